# Optimizing an MI355X kernel written in HIP

```python
import math
import jax
import jax.numpy as jnp
from jax import lax
import numpy as np

D_MODEL = 2048
BATCH = 8
SEQ = 4096
DEPTH = 4

GRID_W = 64
CTX_LEN = 256

BRANCH_W = D_MODEL // 2
N_BRANCH = 3
A_HEAD = 64
A_HEADS = BRANCH_W // A_HEAD
A_DECAY_RANK = 64
A_ICLR_RANK = 64
A_GATE_RANK = 128
A_CONV = 3
N_DIR = 2
LNX_EPS = 64e-5
B_WINDOWS = (2, 4, 8, 16)
B_GROUPS = len(B_WINDOWS)
B_GROUP_W = BRANCH_W // B_GROUPS
C_HEAD = 64
C_VHEAD = 2 * C_HEAD
C_HEADS = BRANCH_W // C_VHEAD
Q_BLOCK = 128
ROPE_BASE = 10000.0
D_FF = 256 * math.ceil(8 * D_MODEL / (3 * 256))
N_MOD = 6
SPLIT_SIZES = (3 * BRANCH_W, N_DIR * A_DECAY_RANK, N_DIR * A_ICLR_RANK, A_GATE_RANK, BRANCH_W, 2 * C_HEADS * C_HEAD, 2 * C_HEADS * C_HEAD, C_HEADS * C_VHEAD, N_BRANCH * D_MODEL)
D_IN = sum(SPLIT_SIZES)

kernel_name = 'hybrid_rwkv7_pool_diffattn_dit_block'

F32 = jnp.float32


def _rms(x, g, eps=1e-6):
    xf = x.astype(F32)
    y = xf * lax.rsqrt(jnp.mean(xf * xf, axis=-1, keepdims=True) + eps)
    return (y * g.astype(F32)).astype(x.dtype)


def _split_cols(z):
    idx = [int(i) for i in np.cumsum(SPLIT_SIZES)[:-1]]
    return jnp.split(z, idx, axis=-1)


def _centred_conv(u, w):
    half = A_CONV // 2
    n = u.shape[1]
    up = jnp.pad(u, ((0, 0), (half, half), (0, 0)))
    return sum(up[:, j:j + n] * w[j] for j in range(A_CONV))


def _head_l2norm(u):
    uh = u.astype(F32).reshape(*u.shape[:-1], A_HEADS, A_HEAD)
    uh = uh / jnp.maximum(jnp.linalg.norm(uh, axis=-1, keepdims=True), 1e-12)
    return uh.reshape(u.shape).astype(u.dtype)


def _rwkv_prepare(z_rkv, z_dec, z_iclr, conv_w, w0, w_up, a0, a_up, kk_scale, ka):
    r, k, v = jnp.split(_centred_conv(z_rkv, conv_w), 3, axis=-1)
    kk = _head_l2norm(k * kk_scale)
    zd = z_dec.reshape(*z_dec.shape[:-1], N_DIR, A_DECAY_RANK)
    za = z_iclr.reshape(*z_iclr.shape[:-1], N_DIR, A_ICLR_RANK)
    dirs = []
    for d in range(N_DIR):
        w_raw = (w0[d] + jnp.tanh(zd[..., d, :]) @ w_up[d]).astype(F32)
        decay = jnp.exp(-jnp.exp(-jax.nn.softplus(-w_raw) - 0.5))
        a = jax.nn.sigmoid(a0[d] + za[..., d, :] @ a_up[d])
        key_d = k * (1 + (a - 1) * ka)
        dirs.append((decay, key_d, kk * a))
    return r, v, kk, dirs


def _wkv_scan(r, w, k, v, a, b, state0, reverse):
    bsz, n = r.shape[:2]

    def tm(u):
        return jnp.moveaxis(u.astype(F32).reshape(bsz, n, A_HEADS, A_HEAD), 1, 0)

    def step(s, inp):
        rt, wt, kt, vt, at, bt = inp
        sa = jnp.einsum('bhvk,bhk->bhv', s, at)
        s = s * wt[:, :, None, :] + sa[..., None] * bt[:, :, None, :] + vt[..., None] * kt[:, :, None, :]
        return s, jnp.einsum('bhvk,bhk->bhv', s, rt)

    s_fin, ys = lax.scan(step, state0, (tm(r), tm(w), tm(k), tm(v), tm(a), tm(b)), reverse=reverse)
    return jnp.moveaxis(ys, 0, 1).reshape(bsz, n, BRANCH_W), s_fin


def _rwkv_output(y, r, v, keys, z_gate, r_k, lnx_w, lnx_b, gate_up):
    shp = r.shape

    def heads(u):
        return u.astype(F32).reshape(*u.shape[:-1], A_HEADS, A_HEAD)

    yh = heads(y)
    mu = jnp.mean(yh, axis=-1, keepdims=True)
    var = jnp.mean(jnp.square(yh - mu), axis=-1, keepdims=True)
    yh = (yh - mu) * lax.rsqrt(var + LNX_EPS) * heads(lnx_w) + heads(lnx_b)
    rh, vh, rkh = heads(r), heads(v), heads(r_k)
    bonus = sum(jnp.sum(rh * heads(kd) * rkh, axis=-1, keepdims=True) for kd in keys) * vh
    g = jax.nn.sigmoid(z_gate) @ gate_up
    return ((yh + bonus).reshape(shp) * g.astype(F32)).astype(v.dtype)


def _pool_mixer(u, pool_w, pool_scale):
    bsz, n, _ = u.shape
    ug = u.reshape(bsz, n, B_GROUPS, B_GROUP_W)
    csum = jnp.pad(jnp.cumsum(ug.astype(F32), axis=1), ((0, 0), (1, 0), (0, 0), (0, 0)))
    t = jnp.arange(n)
    outs = []
    for gi, win in enumerate(B_WINDOWS):
        lo = jnp.clip(t - win // 2, 0, n)
        hi = jnp.clip(t + win // 2, 0, n)
        cg = csum[:, :, gi]
        mean = (cg[:, hi] - cg[:, lo]) / (hi - lo).astype(F32)[None, :, None]
        outs.append(mean - ug[:, :, gi].astype(F32))
    pooled = jnp.stack(outs, axis=2).astype(u.dtype)
    mixed = jnp.einsum('btgc,gcd->btgd', pooled, pool_w)
    return mixed.reshape(bsz, n, BRANCH_W) * pool_scale


def _axial_rope_tables(rows):
    n_freq = C_HEAD // 4
    inv = ROPE_BASE ** (-jnp.arange(n_freq, dtype=F32) / n_freq)
    t_row = jnp.repeat(jnp.arange(rows, dtype=F32), GRID_W)
    t_col = jnp.tile(jnp.arange(GRID_W, dtype=F32), rows)
    ang = jnp.stack([t_row[:, None] * inv, t_col[:, None] * inv], axis=1)
    return jnp.cos(ang), jnp.sin(ang)


def _apply_rope(u, cos, sin):
    shp = u.shape
    uf = u.astype(F32).reshape(*shp[:-1], 2, 2, C_HEAD // 4)
    ua, ub = uf[..., 0, :], uf[..., 1, :]
    cs, sn = cos[None, :, None, None], sin[None, :, None, None]
    out = jnp.stack([ua * cs - ub * sn, ua * sn + ub * cs], axis=-2)
    return out.reshape(shp).astype(u.dtype)


def _heads_qk(z):
    return z.reshape(*z.shape[:-1], C_HEADS, 2, C_HEAD)


def _heads_v(z):
    return z.reshape(*z.shape[:-1], C_HEADS, C_VHEAD)


def _diff_lambda(lam_qk, lam_init):
    lq = lam_qk.astype(F32)
    return jnp.exp(jnp.sum(lq[0] * lq[1])) - jnp.exp(jnp.sum(lq[2] * lq[3])) + lam_init


def _diff_attention(q, k, v, lam, subln_g, lam_init):
    bsz, nq = q.shape[:2]
    nblk = nq // Q_BLOCK
    qb = jnp.moveaxis(q.reshape(bsz, nblk, Q_BLOCK, C_HEADS, 2, C_HEAD), 1, 0)
    scale = C_HEAD ** -0.5

    def one(qi):
        s = jnp.einsum('bqhjd,bkhjd->bhjqk', qi, k).astype(F32) * scale
        p = jax.nn.softmax(s, axis=-1)
        amap = p[:, :, 0] - lam * p[:, :, 1]
        return jnp.einsum('bhqk,bkhe->bqhe', amap.astype(v.dtype), v)

    o = jnp.moveaxis(lax.map(one, qb), 0, 1).reshape(bsz, nq, C_HEADS, C_VHEAD)
    o = _rms(o, subln_g, eps=1e-5) * (1 - lam_init)
    return o.reshape(bsz, nq, BRANCH_W)


def _merge(branches, z_mix, w_branch_l, w_out_l):
    gates = jax.nn.sigmoid(z_mix.reshape(*z_mix.shape[:-1], N_BRANCH, D_MODEL))
    acc = sum(gates[..., i, :] * (y @ w_branch_l[i]) for i, y in enumerate(branches))
    return acc @ w_out_l


def _swiglu(h, w_up, w_down):
    g, u = jnp.split(h @ w_up, 2, axis=-1)
    return (jax.nn.silu(g) * u) @ w_down


def setup_inputs(seed: int = 0) -> dict:
    key = jax.random.key(seed)
    ks = jax.random.split(key, 32)
    L = DEPTH

    def nrm(i, shape, scale):
        return jax.random.normal(ks[i], shape, F32) * scale

    def near_one(i, shape):
        return 1.0 + nrm(i, shape, 0.05)

    return {
        'x': nrm(0, (BATCH, SEQ, D_MODEL), 1.0),
        'c': nrm(1, (BATCH, D_MODEL), 1.0),
        'ctx': nrm(2, (BATCH, CTX_LEN, D_MODEL), 1.0),
        'c_ctx': nrm(3, (D_MODEL,), 1.0),
        'w_ada': nrm(4, (L, D_MODEL, N_MOD * D_MODEL), 0.5 * D_MODEL ** -0.5),
        'b_ada': nrm(5, (L, N_MOD * D_MODEL), 0.02),
        'norm_g': near_one(6, (L, 2, D_MODEL)),
        'w_in': nrm(7, (L, D_MODEL, D_IN), D_MODEL ** -0.5),
        'rkv_conv': jnp.array([0.25, 0.5, 0.25], F32)[None, :, None] + nrm(8, (L, A_CONV, 3 * BRANCH_W), 0.1),
        'decay_w0': jax.random.uniform(ks[9], (L, N_DIR, BRANCH_W), F32, -6.0, 1.0),
        'decay_up': nrm(10, (L, N_DIR, A_DECAY_RANK, BRANCH_W), 0.1),
        'iclr_a0': nrm(11, (L, N_DIR, BRANCH_W), 0.5),
        'iclr_up': nrm(12, (L, N_DIR, A_ICLR_RANK, BRANCH_W), 0.1),
        'gate_up': nrm(13, (L, A_GATE_RANK, BRANCH_W), A_GATE_RANK ** -0.5),
        'k_k': 0.85 + nrm(14, (L, BRANCH_W), 0.05),
        'k_a': near_one(15, (L, BRANCH_W)),
        'r_k': nrm(16, (L, BRANCH_W), 0.1),
        'lnx_w': near_one(17, (L, BRANCH_W)),
        'lnx_b': nrm(18, (L, BRANCH_W), 0.02),
        'pool_w': nrm(19, (L, B_GROUPS, B_GROUP_W, B_GROUP_W), B_GROUP_W ** -0.5),
        'pool_scale': near_one(20, (L, BRANCH_W)),
        'lam_qk': nrm(21, (L, 4, C_HEAD), 0.1),
        'subln_g': near_one(22, (L, C_VHEAD)),
        'w_branch': nrm(23, (L, N_BRANCH, BRANCH_W, D_MODEL), BRANCH_W ** -0.5),
        'w_out': nrm(24, (L, D_MODEL, D_MODEL), D_MODEL ** -0.5),
        'w_ffn_in': nrm(25, (L, D_MODEL, 2 * D_FF), D_MODEL ** -0.5),
        'w_ffn_out': nrm(26, (L, D_FF, D_MODEL), D_FF ** -0.5),
        'final_g': near_one(27, (D_MODEL,)),
    }


def reference(x, c, ctx, c_ctx, w_ada, b_ada, norm_g, w_in, rkv_conv, decay_w0, decay_up, iclr_a0, iclr_up, gate_up, k_k, k_a, r_k, lnx_w, lnx_b, pool_w, pool_scale, lam_qk, subln_g, w_branch, w_out, w_ffn_in, w_ffn_out, final_g):
    bsz, n_tok = x.shape[:2]
    rows = n_tok // GRID_W
    cos, sin = _axial_rope_tables(rows)
    silu_c = jax.nn.silu(c)[:, None, :]
    silu_cc = jax.nn.silu(c_ctx)
    xc = ctx
    for l in range(DEPTH):
        ctx_out = l < DEPTH - 1
        lam_init = 0.8 - 0.6 * math.exp(-0.3 * l)
        mod = jnp.split(silu_c @ w_ada[l] + b_ada[l], N_MOD, axis=-1)
        modc = jnp.split(silu_cc @ w_ada[l] + b_ada[l], N_MOD, axis=-1)

        hl = _rms(x, norm_g[l, 0]) * (1 + mod[1]) + mod[0]
        hc = _rms(xc, norm_g[l, 0]) * (1 + modc[1]) + modc[0]
        zl = _split_cols(hl @ w_in[l])
        zc = _split_cols(hc @ w_in[l])

        pa = (rkv_conv[l], decay_w0[l], decay_up[l], iclr_a0[l], iclr_up[l], k_k[l], k_a[l])
        ra_l, va_l, kk_l, dirs_l = _rwkv_prepare(zl[0], zl[1], zl[2], *pa)
        ra_c, va_c, kk_c, dirs_c = _rwkv_prepare(zc[0], zc[1], zc[2], *pa)
        s0 = jnp.zeros((bsz, A_HEADS, A_HEAD, A_HEAD), F32)
        ya_l = 0.0
        ya_c = 0.0
        for d in range(N_DIR):
            rev = d == 1
            dec_c, key_c, b_c = dirs_c[d]
            y_cd, s_ctx = _wkv_scan(ra_c, dec_c, key_c, va_c, -kk_c, b_c, s0, rev)
            dec_l, key_l, b_l = dirs_l[d]
            y_ld, _ = _wkv_scan(ra_l, dec_l, key_l, va_l, -kk_l, b_l, s_ctx, rev)
            ya_l = ya_l + y_ld
            if ctx_out:
                ya_c = ya_c + y_cd
        pout = (r_k[l], lnx_w[l], lnx_b[l], gate_up[l])
        ya_l = _rwkv_output(ya_l, ra_l, va_l, [dd[1] for dd in dirs_l], zl[3], *pout)

        yb_l = _pool_mixer(zl[4], pool_w[l], pool_scale[l])

        lam = _diff_lambda(lam_qk[l], lam_init)
        q_l = _apply_rope(_heads_qk(zl[5]), cos, sin)
        k_l = _apply_rope(_heads_qk(zl[6]), cos, sin)
        k_c = _heads_qk(zc[6])
        v_c = _heads_v(zc[7])
        k_all = jnp.concatenate([k_l, k_c], axis=1)
        v_all = jnp.concatenate([_heads_v(zl[7]), v_c], axis=1)
        yc_l = _diff_attention(q_l, k_all, v_all, lam, subln_g[l], lam_init)

        mix_l = _merge((ya_l, yb_l, yc_l), zl[8], w_branch[l], w_out[l])
        x = x + mod[2] * mix_l
        if ctx_out:
            ya_c = _rwkv_output(ya_c, ra_c, va_c, [dd[1] for dd in dirs_c], zc[3], *pout)
            yb_c = _pool_mixer(zc[4], pool_w[l], pool_scale[l])
            yc_c = _diff_attention(_heads_qk(zc[5]), k_c, v_c, lam, subln_g[l], lam_init)
            xc = xc + modc[2] * _merge((ya_c, yb_c, yc_c), zc[8], w_branch[l], w_out[l])

        h2 = _rms(x, norm_g[l, 1]) * (1 + mod[4]) + mod[3]
        x = x + mod[5] * _swiglu(h2, w_ffn_in[l], w_ffn_out[l])
        if ctx_out:
            h2c = _rms(xc, norm_g[l, 1]) * (1 + modc[4]) + modc[3]
            xc = xc + modc[5] * _swiglu(h2c, w_ffn_in[l], w_ffn_out[l])
    return _rms(x, final_g)
```

```cpp
#include <hip/hip_runtime.h>
#include <cstdio>
#include <cstdint>

__device__ __forceinline__ int lane_id_asm() { int l; asm volatile("v_mbcnt_lo_u32_b32 %0, -1, 0\n\tv_mbcnt_hi_u32_b32 %0, -1, %0" : "=v"(l)); return l; }

namespace pg8 {
#define PG8_LAS __attribute__((address_space(3)))
typedef unsigned short bf16_t;
typedef short bf16x8 __attribute__((ext_vector_type(8)));
typedef float f32x4 __attribute__((ext_vector_type(4)));
typedef unsigned u32x4 __attribute__((ext_vector_type(4)));
constexpr int BM = 256, BK = 64, HALF = 128, HTB = HALF * BK * 2  , STAGE_BYTES = 8 * HTB, NXCD = 8, WGM = 4;

__host__ __device__ __forceinline__ int lds_byte(int r, int c) { const int st = (r >> 4) * 2 + (c >> 5), rr = r & 15, cc = c & 31, ob = rr * 64 + cc * 2; return st * 1024 + (ob ^ (((ob >> 9) & 1) << 5)); }
__host__ __device__ __forceinline__ void stage_rc(int b, int& R, int& C) { const int st = b / 1024, sb = b % 1024, swz = sb ^ (((sb >> 9) & 1) << 5); R = (st >> 1) * 16 + swz / 64; C = (st & 1) * 32 + (swz % 64) / 2; }
__host__ __device__ __forceinline__ int perm32(int rho) { const int n = rho >> 4, i = rho & 15; return 8 * (i >> 2) + 4 * n + (i & 3); }

struct Unit { int pm, pn; };
struct Gemm { const bf16_t* A; const bf16_t* Bt; int M, N, K, lda; };

struct StaticOrder {
    int nM, nN, nwg, G, c, wgm;
    __host__ __device__ void init(int M, int N, int G_, int c_, int wgm_ = WGM) { nM = M / BM; nN = N / BM; nwg = nM * nN; G = G_; c = c_; wgm = wgm_; }
    __host__ __device__ bool next(int i, Unit& u) const {
        const long L = (long)i * G + c; if (L >= nwg) return false;
        int wgid = (int)L; { const int q = nwg / NXCD, r = nwg % NXCD, xcd = wgid % NXCD, off = wgid / NXCD; wgid = (xcd < r ? xcd * (q + 1) : r * (q + 1) + (xcd - r) * q) + off; }
        const int nig = wgm * nN, gid = wgid / nig, fm = gid * wgm, gsz = (nM - fm) < wgm ? (nM - fm) : wgm;
        u.pm = fm + ((wgid % nig) % gsz); u.pn = (wgid % nig) / gsz; return true;
    }
    __device__ __forceinline__ void a_ready(const Unit&) const {}
    __device__ __forceinline__ void done(const Unit&) const {}
};
typedef __bf16 bf16x2_t __attribute__((ext_vector_type(2)));
typedef float f32x2_t __attribute__((ext_vector_type(2)));
__device__ __forceinline__ unsigned cvt_pk_bf16(float lo, float hi) { const f32x2_t v = {lo, hi}; const bf16x2_t b = __builtin_convertvector(v, bf16x2_t); return __builtin_bit_cast(unsigned, b); }
typedef float f32x2 __attribute__((ext_vector_type(2)));

template <class Epi, class Sched, bool ALIGN_EPI = false, bool SP2 = false>
__device__ __forceinline__ void gemm_phase(PG8_LAS unsigned char* lds, const Gemm g, const Sched& S, const Epi& E, int wave_s) {
    int tid_ = (wave_s << 6) | lane_id_asm(); asm volatile("" : "+v"(tid_)); const int tid = tid_, wid = __builtin_amdgcn_readfirstlane(tid >> 6), lane = tid & 63, wr = wid >> 2, wc = wid & 3, fr = lane & 15, fq = lane >> 4;
    const int K = g.K, nt = K / BK;
    unsigned voffA[2], voffB[2];
#pragma unroll
    for (int i = 0; i < 2; ++i) { int R, C; stage_rc(tid * 16 + i * 8192, R, C); const int Rb = Epi::PERM ? ((R & ~31) + perm32(R & 31)) : R;
        voffA[i] = (unsigned)(R * g.lda + C) * 2u; voffB[i] = (unsigned)(Rb * K + C) * 2u; }
    const size_t kstep = (size_t)(BK * 2);
    const size_t hstepB = (size_t)HALF * K * 2, hstepA = (size_t)HALF * g.lda * 2;
    const size_t tstepA = 2 * hstepA, tstepB = 2 * hstepB;
    const unsigned ldsw = (unsigned)wid * 1024u;
    const int aoff = lds_byte(wr * 64 + fr, fq * 8), boff = lds_byte(wc * 32 + fr, fq * 8);
#define PG8_SA(b, h) (((b) * 2 + (h)) * HTB)
#define PG8_SB(b, h) ((4 + (b) * 2 + (h)) * HTB)
#define PG8_STAGE(bufoff, gbase, voff) do { _Pragma("unroll") for (int _i = 0; _i < 2; ++_i) \
        __builtin_amdgcn_global_load_lds((const unsigned*)((const char*)(gbase) + (voff)[_i]), (PG8_LAS unsigned*)(lds + (bufoff) + ldsw + _i * 8192), 16, 0, 0); } while (0)
#define PG8_LDA(dst, b, h) do { _Pragma("unroll") for (int m = 0; m < 4; ++m) _Pragma("unroll") for (int k = 0; k < 2; ++k) dst[m][k] = *(const PG8_LAS bf16x8*)(lds + PG8_SA(b, h) + aoff + m * 2048 + k * 1024); } while (0)
#define PG8_LDB(dst, b, h) do { _Pragma("unroll") for (int n = 0; n < 2; ++n) _Pragma("unroll") for (int k = 0; k < 2; ++k) dst[n][k] = *(const PG8_LAS bf16x8*)(lds + PG8_SB(b, h) + boff + n * 2048 + k * 1024); } while (0)
#define PG8_MMA(ai, bj, At, Bt) do { __builtin_amdgcn_s_setprio(1); _Pragma("unroll") for (int m = 0; m < 4; ++m) _Pragma("unroll") for (int n = 0; n < 2; ++n) _Pragma("unroll") for (int k = 0; k < 2; ++k) \
        acc[ai][bj][m][n] = __builtin_amdgcn_mfma_f32_16x16x32_bf16(Bt[n][k], At[m][k], acc[ai][bj][m][n], 0, 0, 0); __builtin_amdgcn_s_setprio(0); } while (0)
#define PG8_WAIT_V(n) asm volatile("s_waitcnt vmcnt(" #n ")" ::: "memory")
#define PG8_WAIT_L(n) asm volatile("s_waitcnt lgkmcnt(" #n ")" ::: "memory")
#define PG8_BAR __builtin_amdgcn_s_barrier()
#define PG8_SCHED __builtin_amdgcn_sched_barrier(0)
    Unit cur, nxt; int ui = 0;
    if (!S.next(0, cur)) return;
    f32x4 acc[2][2][4][2];
#pragma unroll
    for (int a = 0; a < 2; ++a)
#pragma unroll
        for (int b = 0; b < 2; ++b)
#pragma unroll
            for (int m = 0; m < 4; ++m)
#pragma unroll
                for (int n = 0; n < 2; ++n) acc[a][b][m][n] = (f32x4){0.f, 0.f, 0.f, 0.f};
    bf16x8 At[4][2], B0[2][2], B1[2][2];
    const char* cA = (const char*)g.A + (size_t)cur.pm * tstepA; const char* cB = (const char*)g.Bt + (size_t)cur.pn * tstepB;
    S.a_ready(cur);
    if constexpr (SP2) {
        PG8_STAGE(PG8_SB(0, 0), cB, voffB); PG8_STAGE(PG8_SB(0, 1), cB + hstepB, voffB); PG8_STAGE(PG8_SA(0, 0), cA, voffA); PG8_STAGE(PG8_SA(0, 1), cA + hstepA, voffA);
        if (wr == 1) PG8_BAR;
        PG8_WAIT_V(2); PG8_BAR;
        PG8_STAGE(PG8_SB(1, 0), cB + kstep, voffB); PG8_STAGE(PG8_SA(1, 0), cA + kstep, voffA); PG8_STAGE(PG8_SB(1, 1), cB + hstepB + kstep, voffB);
        PG8_WAIT_V(6); PG8_BAR;
    } else {
        PG8_STAGE(PG8_SB(0, 0), cB, voffB); PG8_STAGE(PG8_SA(0, 0), cA, voffA); PG8_STAGE(PG8_SB(0, 1), cB + hstepB, voffB); PG8_STAGE(PG8_SA(0, 1), cA + hstepA, voffA);
        if (wr == 1) PG8_BAR;
        PG8_WAIT_V(4); PG8_BAR;
        PG8_STAGE(PG8_SB(1, 0), cB + kstep, voffB); PG8_STAGE(PG8_SA(1, 0), cA + kstep, voffA); PG8_STAGE(PG8_SB(1, 1), cB + hstepB + kstep, voffB);
        PG8_WAIT_V(6); PG8_BAR;
    }
    for (;;) {
        const bool has_next = S.next(ui + 1, nxt);
        const char* nA = has_next ? (const char*)g.A + (size_t)nxt.pm * tstepA : cA; const char* nB = has_next ? (const char*)g.Bt + (size_t)nxt.pn * tstepB : cB;
        for (int t = 0; t < nt; t += 2) {
            const bool last = (t == nt - 2);
            const char* a1 = cA + (size_t)(t + 1) * kstep;
            const char* a2 = last ? nA : cA + (size_t)(t + 2) * kstep; const char* b2 = last ? nB : cB + (size_t)(t + 2) * kstep;
            const char* a3 = a2 + kstep; const char* b3 = b2 + kstep;
            if (last && has_next) S.a_ready(nxt);
            if constexpr (SP2) {
            PG8_LDB(B0, 0, 0); PG8_LDB(B1, 0, 1); PG8_SCHED; PG8_LDA(At, 0, 0); PG8_STAGE(PG8_SA(1, 1), a1 + hstepA, voffA);
            PG8_WAIT_V(8); PG8_WAIT_L(0); PG8_BAR; PG8_MMA(0, 0, At, B0); PG8_MMA(0, 1, At, B1); PG8_BAR; PG8_SCHED;
            PG8_LDA(At, 0, 1); PG8_STAGE(PG8_SB(0, 0), b2, voffB); PG8_STAGE(PG8_SB(0, 1), b2 + hstepB, voffB); PG8_STAGE(PG8_SA(0, 0), a2, voffA);
            PG8_WAIT_V(8); PG8_WAIT_L(0); PG8_BAR; PG8_MMA(1, 0, At, B0); PG8_MMA(1, 1, At, B1); PG8_BAR; PG8_SCHED;
            PG8_LDB(B0, 1, 0); PG8_LDB(B1, 1, 1); PG8_SCHED; PG8_LDA(At, 1, 0); PG8_STAGE(PG8_SA(0, 1), a2 + hstepA, voffA);
            PG8_WAIT_V(8); PG8_WAIT_L(0); PG8_BAR; PG8_MMA(0, 0, At, B0); PG8_MMA(0, 1, At, B1); PG8_BAR; PG8_SCHED;
            PG8_LDA(At, 1, 1); PG8_STAGE(PG8_SB(1, 0), b3, voffB); PG8_STAGE(PG8_SB(1, 1), b3 + hstepB, voffB); PG8_STAGE(PG8_SA(1, 0), a3, voffA);
            PG8_WAIT_V(8); PG8_WAIT_L(0); PG8_BAR; PG8_MMA(1, 0, At, B0); PG8_MMA(1, 1, At, B1); PG8_BAR; PG8_SCHED;
            } else {
            PG8_LDB(B0, 0, 0); PG8_SCHED; PG8_LDA(At, 0, 0); PG8_STAGE(PG8_SA(1, 1), a1 + hstepA, voffA);
            PG8_WAIT_L(8); PG8_BAR; PG8_WAIT_L(0); PG8_MMA(0, 0, At, B0); PG8_BAR; PG8_SCHED;
            PG8_LDB(B1, 0, 1); PG8_STAGE(PG8_SB(0, 0), b2, voffB);
            PG8_BAR; PG8_WAIT_L(0); PG8_MMA(0, 1, At, B1); PG8_BAR;
            PG8_LDA(At, 0, 1); PG8_STAGE(PG8_SA(0, 0), a2, voffA);
            PG8_BAR; PG8_WAIT_L(0); PG8_MMA(1, 0, At, B0); PG8_BAR; PG8_SCHED;
            PG8_STAGE(PG8_SB(0, 1), b2 + hstepB, voffB);
            PG8_WAIT_V(6); PG8_BAR; PG8_MMA(1, 1, At, B1); PG8_BAR;
            PG8_LDB(B0, 1, 0); PG8_SCHED; PG8_LDA(At, 1, 0); PG8_STAGE(PG8_SA(0, 1), a2 + hstepA, voffA);
            PG8_WAIT_L(8); PG8_BAR; PG8_WAIT_L(0); PG8_MMA(0, 0, At, B0); PG8_BAR; PG8_SCHED;
            PG8_LDB(B1, 1, 1); PG8_STAGE(PG8_SB(1, 0), b3, voffB);
            PG8_BAR; PG8_WAIT_L(0); PG8_MMA(0, 1, At, B1); PG8_BAR;
            PG8_LDA(At, 1, 1); PG8_STAGE(PG8_SA(1, 0), a3, voffA);
            PG8_BAR; PG8_WAIT_L(0); PG8_MMA(1, 0, At, B0); PG8_BAR; PG8_SCHED;
            PG8_STAGE(PG8_SB(1, 1), b3 + hstepB, voffB);
            PG8_WAIT_V(6); PG8_BAR; PG8_MMA(1, 1, At, B1); PG8_BAR;
            }
        }
        if constexpr (ALIGN_EPI) { if (wr == 0) PG8_BAR; }
        if constexpr (!Epi::AFTER_DRAIN) {
            const int l2 = lane_id_asm(); E(acc, cur, wr, wc, l2 & 15, l2 >> 4); S.done(cur); }
        if (!has_next) break;
#pragma unroll
        for (int a = 0; a < 2; ++a)
#pragma unroll
            for (int b = 0; b < 2; ++b)
#pragma unroll
                for (int m = 0; m < 4; ++m)
#pragma unroll
                    for (int n = 0; n < 2; ++n) acc[a][b][m][n] = (f32x4){0.f, 0.f, 0.f, 0.f};
        cur = nxt; cA = nA; cB = nB; ++ui;
        if constexpr (ALIGN_EPI) { if (wr == 1) PG8_BAR; }
    }
    PG8_WAIT_V(0);
    if constexpr (!ALIGN_EPI) { if (wr == 0) PG8_BAR; }
    PG8_BAR;
    if constexpr (Epi::AFTER_DRAIN) { E.fused(acc, cur, wr, wc, fr, fq, lds, wid, lane); S.done(cur); }
#undef PG8_SA
#undef PG8_SB
#undef PG8_STAGE
#undef PG8_LDA
#undef PG8_LDB
#undef PG8_MMA
#undef PG8_WAIT_V
#undef PG8_WAIT_L
#undef PG8_BAR
#undef PG8_SCHED
}
}

namespace pg8 {
typedef unsigned u32x2 __attribute__((ext_vector_type(2)));
typedef _Float16 f16x8 __attribute__((ext_vector_type(8)));
__device__ __forceinline__ float sigmoidf_(float x) { return __builtin_amdgcn_rcpf(1.0f + __expf(-x)); }
__device__ __forceinline__ float bf_lo(unsigned w) { return __uint_as_float(w << 16); }
__device__ __forceinline__ float bf_hi(unsigned w) { return __uint_as_float(w & 0xffff0000u); }

struct EpiZ1 {
    static constexpr bool PERM = true, AFTER_DRAIN = false;
    bf16_t* O;
    __device__ __forceinline__ void operator()(const f32x4 (&acc)[2][2][4][2], const Unit& u, int wr, int wc, int fr, int fq) const {
        const int row0 = u.pm * BM + wr * 64 + fr, col0 = u.pn * BM + wc * 32 + 8 * fq;
#pragma unroll
        for (int ai = 0; ai < 2; ++ai)
#pragma unroll
            for (int m = 0; m < 4; ++m) { bf16_t* rowp = O + (size_t)(row0 + ai * HALF + m * 16) * 4608 + col0;
#pragma unroll
                for (int bj = 0; bj < 2; ++bj) { f32x4 v0 = acc[ai][bj][m][0], v1 = acc[ai][bj][m][1];
                    if (bj == 0 && u.pn == 12) {
#pragma unroll
                        for (int j = 0; j < 4; ++j) { v0[j] = tanhf(v0[j]); v1[j] = tanhf(v1[j]); } }
                    if (bj == 0 && u.pn == 13) {
#pragma unroll
                        for (int j = 0; j < 4; ++j) { v0[j] = sigmoidf_(v0[j]); v1[j] = sigmoidf_(v1[j]); } }
                    u32x4 w; w.x = cvt_pk_bf16(v0[0], v0[1]); w.y = cvt_pk_bf16(v0[2], v0[3]); w.z = cvt_pk_bf16(v1[0], v1[1]); w.w = cvt_pk_bf16(v1[2], v1[3]);
                    *(u32x4*)(rowp + bj * HALF) = w; } }
    }
};
struct EpiZ2 {
    static constexpr bool PERM = true, AFTER_DRAIN = false;
    bf16_t* O; const float* cosT; const float* sinT;
    __device__ __forceinline__ void operator()(const f32x4 (&acc)[2][2][4][2], const Unit& u, int wr, int wc, int fr, int fq) const {
        const int row0 = u.pm * BM + wr * 64 + fr;
        if (u.pn >= 8) {
            const int col0 = u.pn * BM + wc * 32 + 8 * fq;
#pragma unroll
            for (int ai = 0; ai < 2; ++ai)
#pragma unroll
                for (int m = 0; m < 4; ++m) { bf16_t* rowp = O + (size_t)(row0 + ai * HALF + m * 16) * 3072 + col0;
#pragma unroll
                    for (int bj = 0; bj < 2; ++bj) { const f32x4 v0 = acc[ai][bj][m][0], v1 = acc[ai][bj][m][1];
                        u32x4 w; w.x = cvt_pk_bf16(v0[0], v0[1]); w.y = cvt_pk_bf16(v0[2], v0[3]); w.z = cvt_pk_bf16(v1[0], v1[1]); w.w = cvt_pk_bf16(v1[2], v1[3]);
                        *(u32x4*)(rowp + bj * HALF) = w; } }
            return;
        }
        const bool rope = u.pm < 128; const int axis = wc & 1;
        const int colg = u.pn * BM + wc * 32 + 4 * fq;
#pragma unroll
        for (int ai = 0; ai < 2; ++ai)
#pragma unroll
            for (int m = 0; m < 4; ++m) { const int row = row0 + ai * HALF + m * 16; bf16_t* rowp = O + (size_t)row * 3072 + colg;
                f32x4 cs = (f32x4){1.f, 1.f, 1.f, 1.f}, sn = (f32x4){0.f, 0.f, 0.f, 0.f};
                if (rope) { const int t = row & 4095, pos = axis ? (t & 63) : (t >> 6); cs = *(const f32x4*)(cosT + pos * 16 + 4 * fq); sn = *(const f32x4*)(sinT + pos * 16 + 4 * fq); }
#pragma unroll
                for (int bj = 0; bj < 2; ++bj) { const f32x4 a = acc[ai][bj][m][0], b = acc[ai][bj][m][1];
                    const f32x4 ra = a * cs - b * sn, rb = a * sn + b * cs;
                    u32x2 wa, wb; wa.x = cvt_pk_bf16(ra[0], ra[1]); wa.y = cvt_pk_bf16(ra[2], ra[3]); wb.x = cvt_pk_bf16(rb[0], rb[1]); wb.y = cvt_pk_bf16(rb[2], rb[3]);
                    *(u32x2*)(rowp + bj * HALF) = wa; *(u32x2*)(rowp + bj * HALF + 16) = wb; } }
    }
};
struct EpiGate {
    static constexpr bool PERM = true, AFTER_DRAIN = false;
    bf16_t* O;
    __device__ __forceinline__ void operator()(const f32x4 (&acc)[2][2][4][2], const Unit& u, int wr, int wc, int fr, int fq) const {
        const int row0 = u.pm * BM + wr * 64 + fr, col0 = u.pn * BM + wc * 32 + 8 * fq;
#pragma unroll
        for (int ai = 0; ai < 2; ++ai)
#pragma unroll
            for (int m = 0; m < 4; ++m) { bf16_t* rowp = O + (size_t)(row0 + ai * HALF + m * 16) * 6144 + col0;
#pragma unroll
                for (int bj = 0; bj < 2; ++bj) { f32x4 v0 = acc[ai][bj][m][0], v1 = acc[ai][bj][m][1];
#pragma unroll
                    for (int j = 0; j < 4; ++j) { v0[j] = sigmoidf_(v0[j]); v1[j] = sigmoidf_(v1[j]); }
                    u32x4 w; w.x = cvt_pk_bf16(v0[0], v0[1]); w.y = cvt_pk_bf16(v0[2], v0[3]); w.z = cvt_pk_bf16(v1[0], v1[1]); w.w = cvt_pk_bf16(v1[2], v1[3]);
                    *(u32x4*)(rowp + bj * HALF) = w; } }
    }
};
struct EpiLr {
    static constexpr bool PERM = true, AFTER_DRAIN = false;
    _Float16* O;
    __device__ __forceinline__ void operator()(const f32x4 (&acc)[2][2][4][2], const Unit& u, int wr, int wc, int fr, int fq) const {
        const int row0 = u.pm * BM + wr * 64 + fr, col0 = u.pn * BM + wc * 32 + 8 * fq;
#pragma unroll
        for (int bj = 0; bj < 2; ++bj)
#pragma unroll
            for (int ai = 0; ai < 2; ++ai)
#pragma unroll
                for (int m = 0; m < 4; ++m) { _Float16* rowp = O + (size_t)(row0 + ai * HALF + m * 16) * 5120 + col0 + bj * HALF;
                    const f32x4 v0 = acc[ai][bj][m][0], v1 = acc[ai][bj][m][1];
                    f16x8 w; w[0] = (_Float16)v0[0]; w[1] = (_Float16)v0[1]; w[2] = (_Float16)v0[2]; w[3] = (_Float16)v0[3]; w[4] = (_Float16)v1[0]; w[5] = (_Float16)v1[1]; w[6] = (_Float16)v1[2]; w[7] = (_Float16)v1[3];
                    *(f16x8*)rowp = w; asm volatile("" ::: "memory"); }
    }
};
template <int PASS> struct EpiMerge {
    static constexpr bool PERM = false, AFTER_DRAIN = false;
    const bf16_t* gates; bf16_t* accb;
    __device__ __forceinline__ void operator()(const f32x4 (&acc)[2][2][4][2], const Unit& u, int wr, int wc, int fr, int fq) const {
        const int row0 = u.pm * BM + wr * 64 + fr, col0 = u.pn * BM + wc * 32 + 4 * fq;
#pragma unroll
        for (int ai = 0; ai < 2; ++ai)
#pragma unroll
            for (int m = 0; m < 4; ++m) { const size_t row = (size_t)(row0 + ai * HALF + m * 16);
#pragma unroll
                for (int bj = 0; bj < 2; ++bj)
#pragma unroll
                    for (int n = 0; n < 2; ++n) { const int c = col0 + bj * HALF + n * 16;
                        const u32x2 gw = *(const u32x2*)(gates + row * 6144 + PASS * 2048 + c);
                        f32x4 v = acc[ai][bj][m][n]; v[0] *= bf_lo(gw.x); v[1] *= bf_hi(gw.x); v[2] *= bf_lo(gw.y); v[3] *= bf_hi(gw.y);
                        if (PASS != 0) { const u32x2 pw = *(const u32x2*)(accb + row * 2048 + c); v[0] += bf_lo(pw.x); v[1] += bf_hi(pw.x); v[2] += bf_lo(pw.y); v[3] += bf_hi(pw.y); }
                        u32x2 w; w.x = cvt_pk_bf16(v[0], v[1]); w.y = cvt_pk_bf16(v[2], v[3]); *(u32x2*)(accb + row * 2048 + c) = w; } }
    }
};
struct EpiRes {
    static constexpr bool PERM = false, AFTER_DRAIN = false;
    const float* xin_l; float* xout_l; const float* xin_c; float* xout_c; const float* mod; float gain;
    __device__ __forceinline__ void operator()(const f32x4 (&acc)[2][2][4][2], const Unit& u, int wr, int wc, int fr, int fq) const {
        const bool lat = u.pm < 128; const int prow = lat ? u.pm * BM : (u.pm - 128) * BM;
        const float* xi = lat ? xin_l : xin_c; float* xo = lat ? xout_l : xout_c; const float* mv = mod + (size_t)(lat ? (u.pm >> 4) : 8) * 12288;
        const int row0 = prow + wr * 64 + fr, col0 = u.pn * BM + wc * 32 + 4 * fq;
        f32x4 mvv[2][2];
#pragma unroll
        for (int bj = 0; bj < 2; ++bj)
#pragma unroll
            for (int n = 0; n < 2; ++n) mvv[bj][n] = *(const f32x4*)(mv + col0 + bj * HALF + n * 16);
#pragma unroll
        for (int ai = 0; ai < 2; ++ai)
#pragma unroll
            for (int m = 0; m < 4; ++m) { const size_t off = (size_t)(row0 + ai * HALF + m * 16) * 2048 + col0;
#pragma unroll
                for (int bj = 0; bj < 2; ++bj)
#pragma unroll
                    for (int n = 0; n < 2; ++n) { const f32x4 b = *(const f32x4*)(xi + off + bj * HALF + n * 16); *(f32x4*)(xo + off + bj * HALF + n * 16) = b + (mvv[bj][n] * gain) * acc[ai][bj][m][n]; } }
    }
};
struct EpiSwiglu {
    static constexpr bool PERM = true, AFTER_DRAIN = false;
    bf16_t* O;
    __device__ __forceinline__ void operator()(const f32x4 (&acc)[2][2][4][2], const Unit& u, int wr, int wc, int fr, int fq) const {
        const int row0 = u.pm * BM + wr * 64 + fr, col0 = u.pn * HALF + wc * 32 + 8 * fq;
#pragma unroll
        for (int ai = 0; ai < 2; ++ai)
#pragma unroll
            for (int m = 0; m < 4; ++m) { bf16_t* rowp = O + (size_t)(row0 + ai * HALF + m * 16) * 5632 + col0;
                f32x4 v0 = acc[ai][0][m][0], v1 = acc[ai][0][m][1]; const f32x4 u0 = acc[ai][1][m][0], u1 = acc[ai][1][m][1];
#pragma unroll
                for (int j = 0; j < 4; ++j) { v0[j] = v0[j] * sigmoidf_(v0[j]) * u0[j]; v1[j] = v1[j] * sigmoidf_(v1[j]) * u1[j]; }
                u32x4 w; w.x = cvt_pk_bf16(v0[0], v0[1]); w.y = cvt_pk_bf16(v0[2], v0[3]); w.z = cvt_pk_bf16(v1[0], v1[1]); w.w = cvt_pk_bf16(v1[2], v1[3]);
                *(u32x4*)rowp = w; }
    }
};
}

namespace att {
using bf16 = unsigned short;
using bf16x8 = __attribute__((ext_vector_type(8))) short;
using s16x4  = __attribute__((ext_vector_type(4))) short;
using f32x16 = __attribute__((ext_vector_type(16))) float;
using u32x4  = __attribute__((ext_vector_type(4))) unsigned;
constexpr int NW = 8, QBLK = 32, KVBLK = 64, LDZ = 3072;
constexpr float SCALE = 0.125f, THR = 8.f;
constexpr int SHM_V = KVBLK * 128 * 2, SHM_K = KVBLK * 64 * 2, SHM_ATTN = 2 * SHM_V + 2 * SHM_K + NW * 64 * 4;
#define ATT_KSWZ(row, colB) ((row) * 128 + ((colB) ^ ((((row) >> 1) & 7) << 4)))
#define ATT_SBAR() __builtin_amdgcn_sched_barrier(0)
__device__ __forceinline__ int crow(int r, int hi) { return (r & 3) + 8 * (r >> 2) + 4 * hi; }
typedef __bf16 bf16x2_t __attribute__((ext_vector_type(2)));
typedef float f32x2_t __attribute__((ext_vector_type(2)));
__device__ __forceinline__ unsigned cvtpk(float lo, float hi) { const f32x2_t v = {lo, hi}; const bf16x2_t b = __builtin_convertvector(v, bf16x2_t); return __builtin_bit_cast(unsigned, b); }
__device__ __forceinline__ bf16x8 ld8(const bf16* p) { return *reinterpret_cast<const bf16x8*>(p); }

__device__ __forceinline__ void partialSM(f32x16& p0, f32x16& p1, float& m_reg, float& mn, float& alpha) {
  constexpr float C = SCALE * 1.4426950408889634f;
  float pmax = p0[0];
#pragma unroll
  for (int r = 1; r < 16; ++r) pmax = fmaxf(pmax, p0[r]);
#pragma unroll
  for (int r = 0; r < 16; ++r) pmax = fmaxf(pmax, p1[r]);
  { auto rr = __builtin_amdgcn_permlane32_swap(__float_as_uint(pmax), __float_as_uint(pmax), false, false);
    pmax = fmaxf(__uint_as_float(rr[0]), __uint_as_float(rr[1])); }
  if (__builtin_expect(__all(pmax - m_reg <= THR / SCALE), 1)) { mn = m_reg; alpha = 1.f; }
  else { mn = fmaxf(m_reg, pmax); alpha = __builtin_amdgcn_exp2f((m_reg - mn) * C); m_reg = mn; }
  const float mnC = -mn * C;
#pragma unroll
  for (int r = 0; r < 16; ++r) p0[r] = fmaf(p0[r], C, mnC);
#pragma unroll
  for (int r = 0; r < 16; ++r) p1[r] = fmaf(p1[r], C, mnC);
#pragma unroll
  for (int r = 0; r < 16; ++r) p0[r] = __builtin_amdgcn_exp2f(p0[r]);
}
__device__ __forceinline__ void finishSM(f32x16& p0, f32x16& p1, float alpha, float& l_reg, bf16x8& pa0, bf16x8& pa1, bf16x8& pa2, bf16x8& pa3) {
#pragma unroll
  for (int r = 0; r < 16; ++r) p1[r] = __builtin_amdgcn_exp2f(p1[r]);
  float ps = 0;
#pragma unroll
  for (int r = 0; r < 16; ++r) ps += p0[r];
#pragma unroll
  for (int r = 0; r < 16; ++r) ps += p1[r];
  { auto rr = __builtin_amdgcn_permlane32_swap(__float_as_uint(ps), __float_as_uint(ps), false, false);
    ps = __uint_as_float(rr[0]) + __uint_as_float(rr[1]); }
  l_reg = l_reg * alpha + ps;
#define ATT_PK4(P, BASE, OUT) do { unsigned a0 = cvtpk(P[BASE + 0], P[BASE + 1]), a1 = cvtpk(P[BASE + 2], P[BASE + 3]);   \
    unsigned b0 = cvtpk(P[BASE + 4], P[BASE + 5]), b1 = cvtpk(P[BASE + 6], P[BASE + 7]);                              \
    auto r0 = __builtin_amdgcn_permlane32_swap(a0, b0, false, false); auto r1 = __builtin_amdgcn_permlane32_swap(a1, b1, false, false); \
    u32x4 w = {r0[0], r1[0], r0[1], r1[1]}; OUT = *reinterpret_cast<bf16x8*>(&w); } while (0)
  ATT_PK4(p0, 0, pa0); ATT_PK4(p0, 8, pa1); ATT_PK4(p1, 0, pa2); ATT_PK4(p1, 8, pa3);
#undef ATT_PK4
}
__device__ __forceinline__ void qkt(f32x16& p0, f32x16& p1, const char* Ks, const bf16x8* qr, int r32, int hi) {
  p0 = f32x16{}; p1 = f32x16{};
#pragma unroll
  for (int d0 = 0; d0 < 4; ++d0) { const int cb = (d0 * 16 + hi * 8) * 2;
    const bf16x8 b0 = *reinterpret_cast<const bf16x8*>(Ks + ATT_KSWZ(r32, cb));
    const bf16x8 b1 = *reinterpret_cast<const bf16x8*>(Ks + ATT_KSWZ(32 + r32, cb));
    p0 = __builtin_amdgcn_mfma_f32_32x32x16_bf16(b0, qr[d0], p0, 0, 0, 0);
    p1 = __builtin_amdgcn_mfma_f32_32x32x16_bf16(b1, qr[d0], p1, 0, 0, 0); }
}
__device__ __forceinline__ int v_st(int k, int c) { const int kk = (k & ~0xC) | ((k & 4) << 1) | ((k & 8) >> 1); return ((kk >> 3) * 4 + (c >> 5)) * 512 + ((kk & 7) * 32 + (c & 31)) * 2; }
__device__ __forceinline__ int v_rd_base(int lane) { return ((lane & 3) << 3) | (((lane >> 2) & 3) << 6) | (((lane >> 4) & 1) << 5) | (((lane >> 5) & 1) << 8); }
constexpr int v_rd_off(int d0, int ks, int half) { return d0 * 512 + ks * 4096 + half * 2048; }
template <int OFF> __device__ __forceinline__ s16x4 tr_read(int vb) {
  s16x4 r; asm volatile("ds_read_b64_tr_b16 %0, %1 offset:%2" : "=&v"(r) : "v"(vb), "i"(OFF) : "memory"); return r;
}
template <int D0> __device__ __forceinline__ void pv_one(f32x16& od, int vb, bf16x8 pa0, bf16x8 pa1, bf16x8 pa2, bf16x8 pa3) {
  const s16x4 l0 = tr_read<v_rd_off(D0, 0, 0)>(vb), h0 = tr_read<v_rd_off(D0, 0, 1)>(vb), l1 = tr_read<v_rd_off(D0, 1, 0)>(vb), h1 = tr_read<v_rd_off(D0, 1, 1)>(vb);
  const s16x4 l2 = tr_read<v_rd_off(D0, 2, 0)>(vb), h2 = tr_read<v_rd_off(D0, 2, 1)>(vb), l3 = tr_read<v_rd_off(D0, 3, 0)>(vb), h3 = tr_read<v_rd_off(D0, 3, 1)>(vb);
  asm volatile("s_waitcnt lgkmcnt(0)" ::: "memory"); ATT_SBAR();
#define ATT_PK(L, H) (bf16x8){L[0], L[1], L[2], L[3], H[0], H[1], H[2], H[3]}
  od = __builtin_amdgcn_mfma_f32_32x32x16_bf16(pa0, ATT_PK(l0, h0), od, 0, 0, 0);
  od = __builtin_amdgcn_mfma_f32_32x32x16_bf16(pa1, ATT_PK(l1, h1), od, 0, 0, 0);
  od = __builtin_amdgcn_mfma_f32_32x32x16_bf16(pa2, ATT_PK(l2, h2), od, 0, 0, 0);
  od = __builtin_amdgcn_mfma_f32_32x32x16_bf16(pa3, ATT_PK(l3, h3), od, 0, 0, 0);
#undef ATT_PK
}
__device__ __forceinline__ void pv_d0(f32x16* o, int vb, bf16x8 pa0, bf16x8 pa1, bf16x8 pa2, bf16x8 pa3) {
  pv_one<0>(o[0], vb, pa0, pa1, pa2, pa3); pv_one<1>(o[1], vb, pa0, pa1, pa2, pa3); pv_one<2>(o[2], vb, pa0, pa1, pa2, pa3); pv_one<3>(o[3], vb, pa0, pa1, pa2, pa3);
}

template <int STREAM>
__device__ __forceinline__ void body(const bf16* __restrict__ Z2, int qrow0, int klat0, int kctx0, int nlat, int NT, int qoff, int koff, int voff,
                                     float* __restrict__ tmp, bf16* __restrict__ Ob  , float lam, const float* __restrict__ subg, float oscale, char* lds, int wave_s) {
  int tid_ = (wave_s << 6) | lane_id_asm(); asm volatile("" : "+v"(tid_));
  const int tid = tid_, wid = tid >> 6, lane = tid & 63, r32 = lane & 31, hi = lane >> 5;
  char* V_lds = lds; char* K_lds = lds + 2 * SHM_V;
  float* ws = (float*)(lds + 2 * SHM_V + 2 * SHM_K) + wid * 64; float* li_l = ws; float* al_l = ws + 32;
  float m_reg = -1e30f, l_reg = 0; f32x16 o[4] = {}; bf16x8 qr[4];
  const bf16* Qw = Z2 + (size_t)(qrow0 + wid * QBLK + r32) * LDZ + qoff + hi * 8;
#pragma unroll
  for (int d0 = 0; d0 < 4; ++d0) qr[d0] = ld8(Qw + d0 * 16);
  const int sr = tid >> 4, sc = (tid & 15) * 8, vst0 = v_st(sr, sc), vst1 = v_st(32 + sr, sc);
  const int kr = tid >> 3, kst = ATT_KSWZ(kr, (tid & 7) * 16), kcol = koff + (tid & 7) * 8;
  const int vb0 = (int)(uintptr_t)V_lds + v_rd_base(lane);
  struct { bf16x8 vs0, vs1, ks0; } sr_[2];
#define ATT_KROW(j) ((j) < nlat ? klat0 + 64 * (j) : kctx0 + 64 * ((j) - nlat))
#define ATT_SLOAD(i, j) do { const int _r0 = ATT_KROW(j); sr_[i].vs0 = ld8(Z2 + (size_t)(_r0 + sr) * LDZ + voff + sc); sr_[i].vs1 = ld8(Z2 + (size_t)(_r0 + 32 + sr) * LDZ + voff + sc); \
    sr_[i].ks0 = ld8(Z2 + (size_t)(_r0 + kr) * LDZ + kcol); } while (0)
#define ATT_SWRITE(b, i) do { *(bf16x8*)(V_lds + (b) * SHM_V + vst0) = sr_[i].vs0; *(bf16x8*)(V_lds + (b) * SHM_V + vst1) = sr_[i].vs1; \
    *(bf16x8*)(K_lds + (b) * SHM_K + kst) = sr_[i].ks0; } while (0)
#define ATT_SWAIT() asm volatile("s_waitcnt vmcnt(3)" ::: "memory")
#define ATT_RESC(a) do { if (__any((a) < 1.f)) { if (hi == 0) al_l[r32] = (a); asm volatile("s_waitcnt lgkmcnt(0)" ::: "memory"); \
    _Pragma("unroll") for (int d = 0; d < 4; ++d) _Pragma("unroll") for (int r = 0; r < 16; ++r) o[d][r] *= al_l[crow(r, hi)]; } } while (0)
  f32x16 pA0, pA1, pB0, pB1; float mnA, mnB, alA, alB; bf16x8 pa0, pa1, pa2, pa3;
  constexpr int SE = 0, SO = 1;
  __syncthreads();
  ATT_SLOAD(SE, 0); asm volatile("s_waitcnt vmcnt(0)" ::: "memory"); ATT_SWRITE(0, SE); __syncthreads();
  qkt(pA0, pA1, K_lds, qr, r32, hi); partialSM(pA0, pA1, m_reg, mnA, alA);
  ATT_SLOAD(SO, 1); if (2 < NT) ATT_SLOAD(SE, 2);
  ATT_SWAIT(); ATT_SWRITE(1, SO); __syncthreads();
  for (int j = 1; j + 1 < NT; j += 2) {
    ATT_SBAR(); qkt(pB0, pB1, K_lds + SHM_K, qr, r32, hi);
    finishSM(pA0, pA1, alA, l_reg, pa0, pa1, pa2, pa3); ATT_SBAR();
    ATT_SLOAD(SO, j + 2); ATT_SBAR();
    pv_d0(o, vb0, pa0, pa1, pa2, pa3); partialSM(pB0, pB1, m_reg, mnB, alB);
    __syncthreads(); ATT_SWAIT(); ATT_SWRITE(0, SE);
    ATT_RESC(alB); __syncthreads();
    ATT_SBAR(); qkt(pA0, pA1, K_lds, qr, r32, hi);
    finishSM(pB0, pB1, alB, l_reg, pa0, pa1, pa2, pa3); ATT_SBAR();
    if (j + 3 < NT) ATT_SLOAD(SE, j + 3); ATT_SBAR();
    pv_d0(o, vb0 + SHM_V, pa0, pa1, pa2, pa3); partialSM(pA0, pA1, m_reg, mnA, alA);
    __syncthreads(); ATT_SWAIT(); ATT_SWRITE(1, SO);
    ATT_RESC(alA); __syncthreads();
  }
  ATT_SBAR(); qkt(pB0, pB1, K_lds + SHM_K, qr, r32, hi);
  finishSM(pA0, pA1, alA, l_reg, pa0, pa1, pa2, pa3); ATT_SBAR();
  pv_d0(o, vb0, pa0, pa1, pa2, pa3); partialSM(pB0, pB1, m_reg, mnB, alB);
  __syncthreads(); ATT_RESC(alB);
  finishSM(pB0, pB1, alB, l_reg, pa0, pa1, pa2, pa3); ATT_SBAR();
  pv_d0(o, vb0 + SHM_V, pa0, pa1, pa2, pa3);
  if (hi == 0) li_l[r32] = l_reg; asm volatile("s_waitcnt lgkmcnt(0)" ::: "memory");
  float rli[16];
#pragma unroll
  for (int r = 0; r < 16; ++r) rli[r] = __builtin_amdgcn_rcpf(li_l[crow(r, hi)]);
  float* tw = tmp + (size_t)(wid * QBLK) * 128;
  if constexpr (STREAM == 0) {
#pragma unroll
    for (int r = 0; r < 16; ++r) { const int orow = crow(r, hi);
#pragma unroll
      for (int d0 = 0; d0 < 4; ++d0) tw[orow * 128 + d0 * 32 + r32] = o[d0][r] * rli[r]; }
  } else {
    float sg[4];
#pragma unroll
    for (int d0 = 0; d0 < 4; ++d0) sg[d0] = subg[d0 * 32 + r32] * oscale;
    bf16* Ow = Ob + (size_t)(wid * QBLK) * 1024;
#pragma unroll
    for (int r = 0; r < 16; ++r) { const int orow = crow(r, hi); float v[4]; float ss = 0.f;
#pragma unroll
      for (int d0 = 0; d0 < 4; ++d0) { v[d0] = tw[orow * 128 + d0 * 32 + r32] - lam * (o[d0][r] * rli[r]); ss += v[d0] * v[d0]; }
#pragma unroll
      for (int of = 1; of < 32; of <<= 1) ss += __shfl_xor(ss, of);
      const float rs = rsqrtf(ss * (1.f / 128.f) + 1e-5f);
#pragma unroll
      for (int d0 = 0; d0 < 4; ++d0) { const unsigned w = cvtpk(v[d0] * rs * sg[d0], 0.f); Ow[(size_t)orow * 1024 + d0 * 32 + r32] = (bf16)(w & 0xffffu); } }
  }
#undef ATT_KROW
#undef ATT_SLOAD
#undef ATT_SWRITE
#undef ATT_SWAIT
#undef ATT_RESC
}
}

#ifndef MK_SPLIT
#define MK_SPLIT 0
#endif
constexpr int DM = 2048, NB = 8, SEQ = 4096, CTXL = 256, DEPTH = 4, BW = 1024;
constexpr int ML = NB * SEQ, MC = NB * CTXL, MT = ML + MC;
constexpr int DIN = 13696, N1 = 4608, N2 = 3072, N3 = 6144, NLR = 5120, KLR = 384, DFF = 5632, NFI = 2 * DFF, NMODC = 6 * DM;
constexpr int NWAVES = 8, NTHR = 512;
constexpr int N_IN = 28;
enum { I_X = 0, I_C, I_CTX, I_CCTX, I_WADA, I_BADA, I_NORMG, I_WIN, I_CONV, I_DW0, I_DUP, I_A0, I_AUP, I_GUP, I_KK, I_KA, I_RK, I_LNW, I_LNB, I_POOLW, I_POOLS, I_LAMQK, I_SUBG, I_WBR, I_WOUT, I_WFI, I_WFO, I_FING };

constexpr size_t MiB = 1u << 20;
constexpr size_t WS_CTL = 0, CTL_ZERO_BYTES = 1 * MiB;
constexpr size_t WS_MODS = 1 * MiB;
constexpr size_t WS_MISC = 3 * MiB;
constexpr size_t WS_W1T = 4 * MiB;
constexpr size_t WS_W2T = WS_W1T + (size_t)N1 * DM * 2;
constexpr size_t WS_W3T = WS_W2T + (size_t)N2 * DM * 2;
constexpr size_t WS_WLRT = WS_W3T + (size_t)N3 * DM * 2;
constexpr size_t WS_WBT = WS_WLRT + (size_t)NLR * KLR * 2;
constexpr size_t WS_WOT = WS_WBT + (size_t)3 * DM * BW * 2;
constexpr size_t WS_WFIT = WS_WOT + (size_t)DM * DM * 2;
constexpr size_t WS_WFOT = WS_WFIT + (size_t)NFI * DM * 2;
constexpr size_t WS_H = WS_WFOT + (size_t)DM * DFF * 2;
constexpr size_t WS_Z = WS_H + (size_t)MT * DM * 2;
constexpr size_t WS_RKV = WS_Z + (size_t)MT * N3 * 2;
constexpr size_t WS_LR = WS_RKV + (size_t)MT * 3072 * 2;
constexpr size_t WS_Y2 = WS_LR + (size_t)MT * NLR * 2;
constexpr size_t WS_POOL = WS_Y2 + (size_t)2 * MT * BW * 2;
constexpr size_t WS_YA = WS_POOL + (size_t)MT * BW * 2;
constexpr size_t WS_YC = WS_YA + (size_t)MT * BW * 2;
constexpr size_t WS_XC = WS_YC + (size_t)MT * BW * 2;
constexpr size_t WS_ATMP = WS_XC + (size_t)MC * DM * 4;
constexpr size_t WS_W2ND = WS_ATMP + (size_t)256 * 256 * 128 * 4;
constexpr size_t WS_END = WS_W2ND + (WS_H - WS_W1T);
#define WSP(l) ((size_t)((l) & 1) * (WS_W2ND - WS_W1T))
static_assert(WS_W1T % 256 == 0 && WS_H % 256 == 0 && WS_Z % 256 == 0 && WS_LR % 256 == 0 && WS_ATMP % 256 == 0, "alignment");
static_assert((size_t)MT * DM * 2 <= (size_t)MT * 3072 * 2, "accb (bf16 [MT][2048]) aliases the post-conv r|k|v buffer");
constexpr int CW_BAR = 4096;

constexpr int RING_BYTES = 131072, LDSCTL_OFF = RING_BYTES, MISC_OFF = LDSCTL_OFF + 320, LDS_BYTES = 147456;

#define GAS __attribute__((address_space(1)))
#define LAS __attribute__((address_space(3)))
typedef unsigned short bf16;
typedef unsigned v4u __attribute__((ext_vector_type(4)));
typedef unsigned v2u __attribute__((ext_vector_type(2)));
typedef float f32x4 __attribute__((ext_vector_type(4)));
typedef float f32x2v __attribute__((ext_vector_type(2)));
typedef _Float16 h2 __attribute__((ext_vector_type(2)));
#define LDS_WAIT() asm volatile("s_waitcnt lgkmcnt(0)" ::: "memory")
#define WG_BAR_LDS() do { asm volatile("s_waitcnt lgkmcnt(0)" ::: "memory"); __builtin_amdgcn_s_barrier(); asm volatile("" ::: "memory"); } while (0)
__device__ __forceinline__ unsigned f2bf(float f) { unsigned u = __builtin_bit_cast(unsigned, f); return (u + 0x7fffu + ((u >> 16) & 1u)) >> 16; }
__device__ __forceinline__ unsigned pk2(float lo, float hi) { return f2bf(lo) | (f2bf(hi) << 16); }
__device__ __forceinline__ float bflo(unsigned w) { return __uint_as_float(w << 16); }
__device__ __forceinline__ float bfhi(unsigned w) { return __uint_as_float(w & 0xffff0000u); }

__device__ __forceinline__ int opaque_s(int x) { asm volatile("" : "+s"(x)); return x; }
__device__ __forceinline__ int opaque_tid(int wave_s) { int t = (wave_s << 6) | lane_id_asm(); asm volatile("" : "+v"(t)); return t; }

#define XB_TMO      128
#define XB_XCNT(j)  (256  + 64 * (j))
#define XB_XSUB(j)  (1280 + 64 * (j))
#define XB_XGEN(j)  (2304 + 64 * (j))
#define XB_TOP      3328
#define XB_TOPGEN   3392
#define XCD_BAR_WORDS 3456
#define XB_SPIN_CAP (1u << 18)

__device__ __forceinline__ unsigned xb_ld(unsigned* p)              { return __hip_atomic_load(p, __ATOMIC_RELAXED, __HIP_MEMORY_SCOPE_AGENT); }
__device__ __forceinline__ unsigned xb_add(unsigned* p, unsigned v) { return __hip_atomic_fetch_add(p, v, __ATOMIC_RELAXED, __HIP_MEMORY_SCOPE_AGENT); }
__device__ __forceinline__ unsigned xb_xcc_id() { return (unsigned)__builtin_amdgcn_s_getreg((3 << 11) | 20) & 0xFu; }
#define XB_SPIN(cond, bar) do { unsigned _sp = 0; while (cond) { __builtin_amdgcn_s_sleep(1); \
    if ((++_sp & 255u) == 0u) { if (xb_ld(&(bar)[XB_TMO])) break; if (_sp > XB_SPIN_CAP) { atomicAdd(&(bar)[XB_TMO], 1u); break; } } } } while (0)

struct XcdBarrier {
    unsigned* bar; unsigned x;
    volatile LAS unsigned* st;
};

__device__ __forceinline__ XcdBarrier xcd_barrier_post(unsigned* bar, volatile LAS unsigned* st, bool t0  ) {
    XcdBarrier b; b.bar = bar; b.x = xb_xcc_id(); b.st = st;
    if (t0) (void)xb_add(&bar[XB_XCNT(b.x)], 1u);
    return b;
}
__device__ __forceinline__ void xcd_barrier_complete(unsigned* bar, unsigned x, unsigned& nloc, unsigned& nx) {
    const unsigned G = gridDim.x * gridDim.y * gridDim.z;
    unsigned sum, cnt, mine, sp = 0u;
    for (;;) {
        sum = 0u; cnt = 0u; mine = 0u;
#pragma unroll
        for (unsigned j = 0; j < 16; ++j) { const unsigned c = xb_ld(&bar[XB_XCNT(j)]); sum += c; cnt += (c > 0u) ? 1u : 0u; mine = (j == x) ? c : mine; }
        if (sum == G) break;
        __builtin_amdgcn_s_sleep(1);
        if ((++sp & 255u) == 0u) { if (xb_ld(&bar[XB_TMO])) break; if (sp > XB_SPIN_CAP) { atomicAdd(&bar[XB_TMO], 1u); break; } }
    }
    nloc = mine > 0u ? mine : 1u; nx = cnt > 0u ? cnt : 1u;
}

__device__ __forceinline__ void xcd_barrier(const XcdBarrier& b, bool t0  ) {
    asm volatile("s_waitcnt vmcnt(0)" ::: "memory");
    __syncthreads();
    if (t0) {
        unsigned* bar = b.bar;
        __builtin_amdgcn_s_waitcnt(0);
        unsigned nloc = b.st[0], nx = b.st[1];
        if (nloc == 0u) { xcd_barrier_complete(bar, b.x, nloc, nx); b.st[0] = nloc; b.st[1] = nx; }
        const unsigned old = xb_add(&bar[XB_XSUB(b.x)], 1u);
        const unsigned gen = old / nloc;
        if (old + 1u == (gen + 1u) * nloc) {
            __builtin_amdgcn_fence(__ATOMIC_RELEASE, "agent");
            asm volatile("s_waitcnt vmcnt(0)" ::: "memory");
            const unsigned og = xb_add(&bar[XB_TOP], 1u);
            const unsigned tg = og / nx;
            if (og + 1u == (tg + 1u) * nx) xb_add(&bar[XB_TOPGEN], 1u);
            else XB_SPIN(xb_ld(&bar[XB_TOPGEN]) == tg, bar);
            __builtin_amdgcn_fence(__ATOMIC_ACQUIRE, "agent");
            xb_add(&bar[XB_XGEN(b.x)], 1u);
            asm volatile("s_waitcnt vmcnt(0)" ::: "memory");
        } else {
            XB_SPIN(xb_ld(&bar[XB_XGEN(b.x)]) == gen, bar);
            __builtin_amdgcn_fence(__ATOMIC_ACQUIRE, "agent");
            asm volatile("s_waitcnt vmcnt(0)" ::: "memory");
        }
    }
    __syncthreads();
}

struct Ctx {
    unsigned char* lds;
    int vcu, G, wave_s;
    const float* const __attribute__((address_space(4)))* ka;
    float* out; unsigned char* ws;
    __device__ __forceinline__ const float* inp(int i) const { const float* const __attribute__((address_space(4)))* p = ka; asm volatile("" : "+s"(p)); return p[i]; }
};

__device__ __forceinline__ void ph_mods(const Ctx& C) {
    const int tid = opaque_tid(C.wave_s), lane = tid & 63, wave = __builtin_amdgcn_readfirstlane(tid >> 6), cG = opaque_s(C.G), cvcu = opaque_s(C.vcu); (void)lane; (void)wave; (void)cG; (void)cvcu;

    float* sc = (float*)C.lds;
    float* red = sc + 9 * 2048;
    float* mods = (float*)(C.ws + WS_MODS);
    for (int i = tid; i < 9 * 2048; i += NTHR) { const int r = i >> 11, k = i & 2047; const float v = r < 8 ? C.inp(I_C)[r * 2048 + k] : C.inp(I_CCTX)[k]; sc[i] = v / (1.f + expf(-v)); }
    __syncthreads();
    for (int it = blockIdx.x; it < DEPTH * (NMODC / 64); it += gridDim.x) {
        const int l = it / (NMODC / 64), nb = it % (NMODC / 64);
        const float* W = C.inp(I_WADA) + (size_t)l * DM * NMODC + nb * 64 + lane;
        float acc[9];
#pragma unroll
        for (int r = 0; r < 9; ++r) acc[r] = 0.f;
        const int kbeg = wave * 256;
#pragma unroll 4
        for (int k4 = 0; k4 < 64; ++k4) { const int k = kbeg + 4 * k4;
            const float w0 = W[(size_t)k * NMODC], w1 = W[(size_t)(k + 1) * NMODC], w2 = W[(size_t)(k + 2) * NMODC], w3 = W[(size_t)(k + 3) * NMODC];
#pragma unroll
            for (int r = 0; r < 9; ++r) { const f32x4 s = *(const f32x4*)(sc + r * 2048 + k); acc[r] += s.x * w0 + s.y * w1 + s.z * w2 + s.w * w3; } }
#pragma unroll
        for (int r = 0; r < 9; ++r) red[(wave * 9 + r) * 64 + lane] = acc[r];
        __syncthreads();
        for (int i = tid; i < 9 * 64; i += NTHR) { const int r = i >> 6, cc = i & 63; float s = 0.f;
#pragma unroll
            for (int w = 0; w < 8; ++w) s += red[(w * 9 + r) * 64 + cc];
            mods[((size_t)l * 9 + r) * NMODC + nb * 64 + cc] = s + C.inp(I_BADA)[l * NMODC + nb * 64 + cc]; }
        __syncthreads();
    }
    if (blockIdx.x == 0) {
        float* cosT = (float*)(C.ws + WS_MISC); float* sinT = cosT + 1024; float* lamv = sinT + 1024;
        for (int i = tid; i < 1024; i += NTHR) { const int pos = i >> 4, f = i & 15; const float inv = powf(10000.0f, -(float)f / 16.0f), ang = (float)pos * inv; cosT[i] = cosf(ang); sinT[i] = sinf(ang); }
        if (tid < DEPTH) { const float* lq = C.inp(I_LAMQK) + tid * 256; float d0 = 0.f, d1 = 0.f;
            for (int i = 0; i < 64; ++i) { d0 += lq[i] * lq[64 + i]; d1 += lq[128 + i] * lq[192 + i]; }
            const float lam_init = 0.8f - 0.6f * expf(-0.3f * (float)tid);
            lamv[tid] = expf(d0) - expf(d1) + lam_init; }
    }
}

__device__ __forceinline__ void ph_norm(const Ctx& C, int l, int which, int Mrows) {
    const int tid = opaque_tid(C.wave_s), lane = tid & 63, wave = __builtin_amdgcn_readfirstlane(tid >> 6), cG = opaque_s(C.G), cvcu = opaque_s(C.vcu); (void)lane; (void)wave; (void)cG; (void)cvcu;

    const int gw = cvcu * NWAVES + wave, NGW = cG * NWAVES;
    const float* g = C.inp(I_NORMG) + (l * 2 + which) * DM;
    const float* mods = (const float*)(C.ws + WS_MODS) + (size_t)l * 9 * NMODC;
    const bool first = (l == 0 && which == 0);
    bf16* H = (bf16*)(C.ws + WS_H);
    f32x4 gv[8];
#pragma unroll
    for (int j = 0; j < 8; ++j) gv[j] = *(const f32x4*)(g + 4 * lane + 256 * j);
    for (int m = gw; m < Mrows; m += NGW) {
        const float* xr; int r;
        if (m < ML) { xr = (first ? C.inp(I_X) : C.out) + (size_t)m * DM; r = m >> 12; } else { xr = (first ? C.inp(I_CTX) : (const float*)(C.ws + WS_XC)) + (size_t)(m - ML) * DM; r = 8; }
        const float* shift = mods + (size_t)r * NMODC + (which ? 3 : 0) * DM; const float* scale = mods + (size_t)r * NMODC + (which ? 4 : 1) * DM;
        f32x4 v[8]; float s = 0.f;
#pragma unroll
        for (int j = 0; j < 8; ++j) { v[j] = *(const f32x4*)(xr + 4 * lane + 256 * j); s += (v[j].x * v[j].x + v[j].y * v[j].y) + (v[j].z * v[j].z + v[j].w * v[j].w); }
#pragma unroll
        for (int o = 1; o < 64; o <<= 1) s += __shfl_xor(s, o);
        const float rstd = rsqrtf(s * (1.f / DM) + 1e-6f);
        unsigned long long* o8 = (unsigned long long*)(H + (size_t)m * DM) + lane;
#pragma unroll
        for (int j = 0; j < 8; ++j) { const f32x4 sh = *(const f32x4*)(shift + 4 * lane + 256 * j), scv = *(const f32x4*)(scale + 4 * lane + 256 * j);
            const f32x4 y = (v[j] * rstd) * gv[j] * (scv + 1.0f) + sh;
            o8[64 * j] = (unsigned long long)pk2(y.x, y.y) | ((unsigned long long)pk2(y.z, y.w) << 32); }
    }
}
__device__ __forceinline__ void ph_final(const Ctx& C) {
    const int tid = opaque_tid(C.wave_s), lane = tid & 63, wave = __builtin_amdgcn_readfirstlane(tid >> 6), cG = opaque_s(C.G), cvcu = opaque_s(C.vcu); (void)lane; (void)wave; (void)cG; (void)cvcu;

    const int gw = cvcu * NWAVES + wave, NGW = cG * NWAVES;
    const float* g = C.inp(I_FING);
    for (int m = gw; m < ML; m += NGW) {
        float* xr = C.out + (size_t)m * DM; f32x4 v[8]; float s = 0.f;
#pragma unroll
        for (int j = 0; j < 8; ++j) { v[j] = *(const f32x4*)(xr + 4 * lane + 256 * j); s += (v[j].x * v[j].x + v[j].y * v[j].y) + (v[j].z * v[j].z + v[j].w * v[j].w); }
#pragma unroll
        for (int o = 1; o < 64; o <<= 1) s += __shfl_xor(s, o);
        const float rstd = rsqrtf(s * (1.f / DM) + 1e-6f);
#pragma unroll
        for (int j = 0; j < 8; ++j) { const f32x4 gv = *(const f32x4*)(g + 4 * lane + 256 * j); *(f32x4*)(xr + 4 * lane + 256 * j) = (v[j] * rstd) * gv; }
    }
}

template <class SrcFn>
__device__ __forceinline__ void tr_item(const float* W, int ldw, int ksrc0, const SrcFn& src, bf16* WT, int ldt, int n0, int kdst0, float* scr, int lane) {
    const int scol = src(n0 + (lane & 31));
#pragma unroll 8
    for (int i = 0; i < 32; ++i) { const int kk = 2 * i + (lane >> 5); scr[kk * 33 + (lane & 31)] = scol >= 0 ? W[(size_t)(ksrc0 + kk) * ldw + scol] : 0.f; }
    LDS_WAIT();
    const int c = lane & 7;
#pragma unroll
    for (int j = 0; j < 4; ++j) { const int n = (lane >> 3) + 8 * j; const float* s = scr + (8 * c) * 33 + n;
        v4u o; o.x = pk2(s[0 * 33], s[1 * 33]); o.y = pk2(s[2 * 33], s[3 * 33]); o.z = pk2(s[4 * 33], s[5 * 33]); o.w = pk2(s[6 * 33], s[7 * 33]);
        *(v4u*)(WT + (size_t)(n0 + n) * ldt + kdst0 + 8 * c) = o; }
    LDS_WAIT();
}
struct SrcOff { int off, lim; __device__ __forceinline__ int operator()(int n) const { return n < lim ? off + n : -1; } };
struct SrcQkv { __device__ __forceinline__ int operator()(int n) const {
    if (n >= 2048) return 6528 + (n - 2048); const int G = n >> 5, w = n & 31, u = w >> 3, nn = (w >> 2) & 1, j = w & 3; return 4480 + 32 * G + 16 * nn + 4 * u + j; } };
struct SrcFfi { __device__ __forceinline__ int operator()(int n) const { const int pn = n >> 8, bj = (n >> 7) & 1, c = n & 127; return bj * DFF + 128 * pn + c; } };

__device__ __forceinline__ void ph_wprep(const Ctx& C, int l) {
    const int tid = opaque_tid(C.wave_s), lane = tid & 63, wave = __builtin_amdgcn_readfirstlane(tid >> 6), cG = opaque_s(C.G), cvcu = opaque_s(C.vcu); (void)lane; (void)wave; (void)cG; (void)cvcu;

    float* scr = (float*)(C.lds + wave * 16384);
    const int gw = cvcu * NWAVES + wave, NGW = cG * NWAVES;
    const float* win = C.inp(I_WIN) + (size_t)l * DM * DIN;
    constexpr int I1 = 32 * (N1 / 32), I2 = 32 * (N2 / 32), I3 = 32 * (N3 / 32), ILR = 6 * (NLR / 32), IB = 16 * 64, IO = 32 * 64, IFI = 32 * (NFI / 32), IFO = 88 * 64;
    constexpr int NITEMS = I1 + I2 + I3 + ILR + 2 * IB + IO + IFI + IFO;
    for (int it = gw; it < NITEMS; it += NGW) {
        int r = it;
        if (r < I1) { const int kb = r / (N1 / 32), nb = r % (N1 / 32); tr_item(win, DIN, 64 * kb, SrcOff{0, 4480}, (bf16*)(C.ws + WSP(l) + WS_W1T), DM, 32 * nb, 64 * kb, scr, lane); continue; } r -= I1;
        if (r < I2) { const int kb = r / (N2 / 32), nb = r % (N2 / 32); tr_item(win, DIN, 64 * kb, SrcQkv{}, (bf16*)(C.ws + WSP(l) + WS_W2T), DM, 32 * nb, 64 * kb, scr, lane); continue; } r -= I2;
        if (r < I3) { const int kb = r / (N3 / 32), nb = r % (N3 / 32); tr_item(win, DIN, 64 * kb, SrcOff{7552, N3}, (bf16*)(C.ws + WSP(l) + WS_W3T), DM, 32 * nb, 64 * kb, scr, lane); continue; } r -= I3;
        if (r < ILR) { const int kb = r / (NLR / 32), nb = r % (NLR / 32), n0 = 32 * nb, reg = n0 >> 10;
            const bool valid = reg < 4 ? (kb == reg) : (kb >= 4);
            const float* W = reg < 2 ? C.inp(I_DUP) + (size_t)(l * 2 + reg) * 64 * BW : reg < 4 ? C.inp(I_AUP) + (size_t)(l * 2 + reg - 2) * 64 * BW : C.inp(I_GUP) + (size_t)l * 128 * BW;
            const int ks = reg < 4 ? 0 : 64 * (kb - 4);
            tr_item(W, BW, ks, SrcOff{valid ? -(reg << 10) : -(1 << 30), valid ? (1 << 30) : 0}, (bf16*)(C.ws + WSP(l) + WS_WLRT), KLR, n0, 64 * kb, scr, lane); continue; } r -= ILR;
        if (r < 2 * IB) { const int i = r / IB ? 2 : 0, q = r % IB, kb = q / 64, nb = q % 64;
            tr_item(C.inp(I_WBR) + (size_t)(l * 3 + i) * BW * DM, DM, 64 * kb, SrcOff{0, DM}, (bf16*)(C.ws + WSP(l) + WS_WBT) + (size_t)i * DM * BW, BW, 32 * nb, 64 * kb, scr, lane); continue; } r -= 2 * IB;
        if (r < IO) { const int kb = r / 64, nb = r % 64; tr_item(C.inp(I_WOUT) + (size_t)l * DM * DM, DM, 64 * kb, SrcOff{0, DM}, (bf16*)(C.ws + WSP(l) + WS_WOT), DM, 32 * nb, 64 * kb, scr, lane); continue; } r -= IO;
        if (r < IFI) { const int kb = r / (NFI / 32), nb = r % (NFI / 32); tr_item(C.inp(I_WFI) + (size_t)l * DM * NFI, NFI, 64 * kb, SrcFfi{}, (bf16*)(C.ws + WSP(l) + WS_WFIT), DM, 32 * nb, 64 * kb, scr, lane); continue; } r -= IFI;
        { const int kb = r / 64, nb = r % 64; tr_item(C.inp(I_WFO) + (size_t)l * DFF * DM, DM, 64 * kb, SrcOff{0, DM}, (bf16*)(C.ws + WSP(l) + WS_WFOT), DFF, 32 * nb, 64 * kb, scr, lane); }
    }
    __syncthreads();
    { float* wbs = (float*)C.lds;
      const float* wb1 = C.inp(I_WBR) + (size_t)(l * 3 + 1) * BW * DM; bf16* WT = (bf16*)(C.ws + WSP(l) + WS_WBT) + (size_t)1 * DM * BW;
      for (int it = cvcu; it < 256; it += cG) { const int g = it >> 6, n0 = (it & 63) * 32;
          for (int i = tid; i < 8192; i += NTHR) { const int d = i >> 5, nn = i & 31; wbs[i] = C.inp(I_POOLS)[l * BW + g * 256 + d] * wb1[(size_t)(g * 256 + d) * DM + n0 + nn]; }
          __syncthreads();
          const int c = tid & 255, nh = tid >> 8; const float* pw = C.inp(I_POOLW) + ((size_t)(l * 4 + g) * 256 + c) * 256;
          float acc[16];
#pragma unroll
          for (int j = 0; j < 16; ++j) acc[j] = 0.f;
          for (int d4 = 0; d4 < 64; ++d4) { const f32x4 p = *(const f32x4*)(pw + 4 * d4);
#pragma unroll
              for (int q = 0; q < 4; ++q) { const float pv = p[q]; const float* wr = wbs + (4 * d4 + q) * 32 + 16 * nh;
#pragma unroll
                  for (int j4 = 0; j4 < 4; ++j4) { const f32x4 w = *(const f32x4*)(wr + 4 * j4); acc[4 * j4] += pv * w.x; acc[4 * j4 + 1] += pv * w.y; acc[4 * j4 + 2] += pv * w.z; acc[4 * j4 + 3] += pv * w.w; } } }
#pragma unroll
          for (int j = 0; j < 16; ++j) WT[(size_t)(n0 + 16 * nh + j) * BW + g * 256 + c] = (bf16)f2bf(acc[j]);
          __syncthreads(); } }
}

__device__ __forceinline__ void ph_convpool(const Ctx& C, int l) {
    const int tid = opaque_tid(C.wave_s), lane = tid & 63, wave = __builtin_amdgcn_readfirstlane(tid >> 6), cG = opaque_s(C.G), cvcu = opaque_s(C.vcu); (void)lane; (void)wave; (void)cG; (void)cvcu;

    const bf16* z1 = (const bf16*)(C.ws + WS_Z); bf16* rkv = (bf16*)(C.ws + WS_RKV); bf16* pooled = (bf16*)(C.ws + WS_POOL);
    const int per = (MT + cG - 1) / cG, m0 = cvcu * per, m1 = (m0 + per < MT) ? m0 + per : MT;
    if (tid < 384) {
        const int col = tid * 8; const float* cw = C.inp(I_CONV) + (size_t)l * 3 * 3072 + col;
        float w[3][8];
#pragma unroll
        for (int j = 0; j < 3; ++j) { const f32x4 a = *(const f32x4*)(cw + j * 3072), b = *(const f32x4*)(cw + j * 3072 + 4); w[j][0] = a.x; w[j][1] = a.y; w[j][2] = a.z; w[j][3] = a.w; w[j][4] = b.x; w[j][5] = b.y; w[j][6] = b.z; w[j][7] = b.w; }
        int m = m0;
        for (; m + 8 <= m1; m += 8) {
            const int t0 = m < ML ? (m & 4095) : ((m - ML) & 255), n = m < ML ? SEQ : CTXL;
            v4u z[10];
#pragma unroll
            for (int r = 0; r < 10; ++r) { int mr = m - 1 + r; mr = mr < 0 ? 0 : (mr > MT - 1 ? MT - 1 : mr); z[r] = *(const v4u*)(z1 + (size_t)mr * N1 + col); }
#pragma unroll
            for (int r = 0; r < 8; ++r) { const bool hp = (t0 + r > 0), hn = (t0 + r < n - 1); v4u o;
#pragma unroll
                for (int q = 0; q < 4; ++q) { const unsigned zpq = hp ? z[r][q] : 0u, znq = hn ? z[r + 2][q] : 0u, zcq = z[r + 1][q];
                    const float lo = w[0][2 * q] * bflo(zpq) + w[1][2 * q] * bflo(zcq) + w[2][2 * q] * bflo(znq);
                    const float hi = w[0][2 * q + 1] * bfhi(zpq) + w[1][2 * q + 1] * bfhi(zcq) + w[2][2 * q + 1] * bfhi(znq); o[q] = pk2(lo, hi); }
                *(v4u*)(rkv + (size_t)(m + r) * 3072 + col) = o; }
        }
        for (; m < m1; ++m) {
            const int t = m < ML ? (m & 4095) : ((m - ML) & 255), n = m < ML ? SEQ : CTXL;
            const v4u zc = *(const v4u*)(z1 + (size_t)m * N1 + col);
            v4u zp = (v4u){0u, 0u, 0u, 0u}, zn = (v4u){0u, 0u, 0u, 0u};
            if (t > 0) zp = *(const v4u*)(z1 + (size_t)(m - 1) * N1 + col);
            if (t < n - 1) zn = *(const v4u*)(z1 + (size_t)(m + 1) * N1 + col);
            v4u o;
#pragma unroll
            for (int q = 0; q < 4; ++q) { const float lo = w[0][2 * q] * bflo(zp[q]) + w[1][2 * q] * bflo(zc[q]) + w[2][2 * q] * bflo(zn[q]);
                const float hi = w[0][2 * q + 1] * bfhi(zp[q]) + w[1][2 * q + 1] * bfhi(zc[q]) + w[2][2 * q + 1] * bfhi(zn[q]); o[q] = pk2(lo, hi); }
            *(v4u*)(rkv + (size_t)m * 3072 + col) = o;
        }
    } else {
        const int col = (tid - 384) * 8, gi = col >> 8, half = 1 << gi;
        float s[8];
#pragma unroll
        for (int q = 0; q < 8; ++q) s[q] = 0.f;
        int m = m0;
        for (; m + 8 <= m1; m += 8) {
            const int t0 = m < ML ? (m & 4095) : ((m - ML) & 255), n = m < ML ? SEQ : CTXL;
            const bf16* zb = z1 + (size_t)(m - t0) * N1 + 3456 + col;
            v4u zi[8], zo[8], zc[8];
#pragma unroll
            for (int r = 0; r < 8; ++r) { const int t = t0 + r; int ti = t - 1 + half, to = t - 1 - half; ti = ti > n - 1 ? n - 1 : ti; to = to < 0 ? 0 : to;
                zi[r] = *(const v4u*)(zb + (size_t)ti * N1); zo[r] = *(const v4u*)(zb + (size_t)to * N1); zc[r] = *(const v4u*)(zb + (size_t)t * N1); }
            if (m == m0 || t0 == 0) {
                const int lo = t0 - half > 0 ? t0 - half : 0, hi = t0 + half < n ? t0 + half : n;
#pragma unroll
                for (int q = 0; q < 8; ++q) s[q] = 0.f;
                for (int tt = lo; tt < hi; ++tt) { const v4u z = *(const v4u*)(zb + (size_t)tt * N1);
#pragma unroll
                    for (int q = 0; q < 4; ++q) { s[2 * q] += bflo(z[q]); s[2 * q + 1] += bfhi(z[q]); } }
            } else {
                const bool vi = (t0 - 1 + half < n), vo = (t0 - 1 - half >= 0);
#pragma unroll
                for (int q = 0; q < 4; ++q) { const unsigned a = vi ? zi[0][q] : 0u, b2 = vo ? zo[0][q] : 0u; s[2 * q] += bflo(a) - bflo(b2); s[2 * q + 1] += bfhi(a) - bfhi(b2); }
            }
#pragma unroll
            for (int r = 0; r < 8; ++r) { const int t = t0 + r;
                if (r > 0) { const bool vi = (t - 1 + half < n), vo = (t - 1 - half >= 0);
#pragma unroll
                    for (int q = 0; q < 4; ++q) { const unsigned a = vi ? zi[r][q] : 0u, b2 = vo ? zo[r][q] : 0u; s[2 * q] += bflo(a) - bflo(b2); s[2 * q + 1] += bfhi(a) - bfhi(b2); } }
                const int lo = t - half > 0 ? t - half : 0, hi = t + half < n ? t + half : n; const float inv = 1.f / (float)(hi - lo);
                v4u o;
#pragma unroll
                for (int q = 0; q < 4; ++q) o[q] = pk2(s[2 * q] * inv - bflo(zc[r][q]), s[2 * q + 1] * inv - bfhi(zc[r][q]));
                *(v4u*)(pooled + (size_t)(m + r) * BW + col) = o; }
        }
        for (; m < m1; ++m) {
            const int t = m < ML ? (m & 4095) : ((m - ML) & 255), n = m < ML ? SEQ : CTXL;
            const bf16* zb = z1 + (size_t)(m - t) * N1 + 3456 + col;
            const int lo = t - half > 0 ? t - half : 0, hi = t + half < n ? t + half : n;
            if (m == m0 || t == 0) {
#pragma unroll
                for (int q = 0; q < 8; ++q) s[q] = 0.f;
                for (int tt = lo; tt < hi; ++tt) { const v4u z = *(const v4u*)(zb + (size_t)tt * N1);
#pragma unroll
                    for (int q = 0; q < 4; ++q) { s[2 * q] += bflo(z[q]); s[2 * q + 1] += bfhi(z[q]); } }
            } else {
                v4u zin = (v4u){0u, 0u, 0u, 0u}, zout = (v4u){0u, 0u, 0u, 0u};
                if (t - 1 + half < n) zin = *(const v4u*)(zb + (size_t)(t - 1 + half) * N1);
                if (t - 1 - half >= 0) zout = *(const v4u*)(zb + (size_t)(t - 1 - half) * N1);
#pragma unroll
                for (int q = 0; q < 4; ++q) { s[2 * q] += bflo(zin[q]) - bflo(zout[q]); s[2 * q + 1] += bfhi(zin[q]) - bfhi(zout[q]); }
            }
            const v4u zc = *(const v4u*)(zb + (size_t)t * N1); const float inv = 1.f / (float)(hi - lo);
            v4u o;
#pragma unroll
            for (int q = 0; q < 4; ++q) o[q] = pk2(s[2 * q] * inv - bflo(zc[q]), s[2 * q + 1] * inv - bfhi(zc[q]));
            *(v4u*)(pooled + (size_t)m * BW + col) = o;
        }
    }
}
__device__ __forceinline__ float fsigmoid(float x) { return __builtin_amdgcn_rcpf(1.0f + __expf(-x)); }
__device__ __forceinline__ float red8(float x) {
    x += __builtin_bit_cast(float, __builtin_amdgcn_update_dpp(0, __builtin_bit_cast(int, x), 0xB1, 0xF, 0xF, true));
    x += __builtin_bit_cast(float, __builtin_amdgcn_update_dpp(0, __builtin_bit_cast(int, x), 0x4E, 0xF, 0xF, true));
    x += __builtin_bit_cast(float, __builtin_amdgcn_update_dpp(0, __builtin_bit_cast(int, x), 0x141, 0xF, 0xF, true));
    return x;
}
__device__ __forceinline__ void ph_scan(const Ctx& C, int l) {
    float* op = (float*)C.lds;
    float* yb = op + 16 * 384;
    const bf16* rkv = (const bf16*)(C.ws + WS_RKV); const _Float16* lr = (const _Float16*)(C.ws + WS_LR); bf16* ydir = (bf16*)(C.ws + WS_Y2);
    const int tid = opaque_tid(C.wave_s), lane = tid & 63, wv = __builtin_amdgcn_readfirstlane(tid >> 6), ss = tid >> 5, cp = tid & 31;
    const int vl = lane >> 3, kq = lane & 7;
    for (int it = blockIdx.x; it < 256; it += gridDim.x) {
        const int b = it >> 5, h = (it >> 1) & 15, dir = it & 1, ch = h * 64 + 2 * cp;
        const float kks0 = C.inp(I_KK)[l * BW + ch], kks1 = C.inp(I_KK)[l * BW + ch + 1], ka0 = C.inp(I_KA)[l * BW + ch], ka1 = C.inp(I_KA)[l * BW + ch + 1];
        const float dw0 = C.inp(I_DW0)[(l * 2 + dir) * BW + ch], dw1 = C.inp(I_DW0)[(l * 2 + dir) * BW + ch + 1], ia0 = C.inp(I_A0)[(l * 2 + dir) * BW + ch], ia1 = C.inp(I_A0)[(l * 2 + dir) * BW + ch + 1];
        f32x2v S[4];
#pragma unroll
        for (int i = 0; i < 4; ++i) S[i] = (f32x2v){0.f, 0.f};
        unsigned rr, rk, rv; h2 rs, ra;
#define SCAN_ROW(g) ((g) < 256 ? (ML + b * 256 + (dir ? 255 - (g) : (g))) : (b * 4096 + (dir ? 4095 - ((g) - 256) : ((g) - 256))))
#define SCAN_LOAD(c) do { const size_t _row = (size_t)SCAN_ROW(16 * (c) + ss); rr = *(const unsigned*)(rkv + _row * 3072 + ch); rk = *(const unsigned*)(rkv + _row * 3072 + 1024 + ch); rv = *(const unsigned*)(rkv + _row * 3072 + 2048 + ch); \
        rs = *(const h2*)(lr + _row * NLR + dir * 1024 + ch); ra = *(const h2*)(lr + _row * NLR + 2048 + dir * 1024 + ch); } while (0)
        SCAN_LOAD(0);
        for (int c = 0; c < 272; ++c) {
            { const float k0 = bflo(rk), k1 = bfhi(rk), q0 = k0 * kks0, q1 = k1 * kks1; float sq = q0 * q0 + q1 * q1;
#pragma unroll
              for (int o = 1; o < 32; o <<= 1) sq += __shfl_xor(sq, o);
              const float inv = __builtin_amdgcn_rsqf(fmaxf(sq, 1e-24f)), n0 = q0 * inv, n1 = q1 * inv;
              const float a0 = fsigmoid((float)ra[0] + ia0), a1 = fsigmoid((float)ra[1] + ia1);
              const float sd0 = fsigmoid((float)rs[0] + dw0), sd1 = fsigmoid((float)rs[1] + dw1);
              float* o = op + ss * 384 + 2 * cp;
              *(f32x2v*)(o) = (f32x2v){-n0, -n1};
              *(f32x2v*)(o + 64) = (f32x2v){__expf(-0.60653065971f * sd0), __expf(-0.60653065971f * sd1)};
              *(f32x2v*)(o + 128) = (f32x2v){n0 * a0, n1 * a1};
              *(f32x2v*)(o + 192) = (f32x2v){k0 * (1.f + (a0 - 1.f) * ka0), k1 * (1.f + (a1 - 1.f) * ka1)};
              *(f32x2v*)(o + 256) = (f32x2v){bflo(rr), bfhi(rr)};
              *(f32x2v*)(o + 320) = (f32x2v){bflo(rv), bfhi(rv)}; }
            if (c + 1 < 272) SCAN_LOAD(c + 1);
            WG_BAR_LDS();
#pragma unroll
            for (int s = 0; s < 16; ++s) {
                const float* o = op + s * 384 + 8 * kq;
                const f32x4 a0 = *(const f32x4*)(o), a1 = *(const f32x4*)(o + 4), w0 = *(const f32x4*)(o + 64), w1 = *(const f32x4*)(o + 68), b0 = *(const f32x4*)(o + 128), b1 = *(const f32x4*)(o + 132);
                const f32x4 d0 = *(const f32x4*)(o + 192), d1 = *(const f32x4*)(o + 196), r0 = *(const f32x4*)(o + 256), r1 = *(const f32x4*)(o + 260);
                const float vv = op[s * 384 + 320 + 8 * wv + vl];
#define SC_LO(q) ((f32x2v){(q).x, (q).y})
#define SC_HI(q) ((f32x2v){(q).z, (q).w})
                f32x2v pa = S[0] * SC_LO(a0); pa = S[1] * SC_HI(a0) + pa; pa = S[2] * SC_LO(a1) + pa; pa = S[3] * SC_HI(a1) + pa;
                const float sa = red8(pa.x + pa.y);
                const f32x2v sa2 = (f32x2v){sa, sa}, vv2 = (f32x2v){vv, vv};
                S[0] = S[0] * SC_LO(w0) + (sa2 * SC_LO(b0) + vv2 * SC_LO(d0)); S[1] = S[1] * SC_HI(w0) + (sa2 * SC_HI(b0) + vv2 * SC_HI(d0));
                S[2] = S[2] * SC_LO(w1) + (sa2 * SC_LO(b1) + vv2 * SC_LO(d1)); S[3] = S[3] * SC_HI(w1) + (sa2 * SC_HI(b1) + vv2 * SC_HI(d1));
                f32x2v py = S[0] * SC_LO(r0); py = S[1] * SC_HI(r0) + py; py = S[2] * SC_LO(r1) + py; py = S[3] * SC_HI(r1) + py;
                const float y = red8(py.x + py.y);
#undef SC_LO
#undef SC_HI
                if (kq == 0) yb[s * 64 + 8 * wv + vl] = y;
            }
            WG_BAR_LDS();
            { const f32x2v acc = *(const f32x2v*)(yb + ss * 64 + 2 * cp);
              const size_t row = (size_t)SCAN_ROW(16 * c + ss);
              *(unsigned*)(ydir + ((size_t)dir * MT + row) * BW + ch) = pk2(acc.x, acc.y); }
        }
        WG_BAR_LDS();
#undef SCAN_LOAD
#undef SCAN_ROW
    }
}

#ifndef SCAN_CHUNKED
#define SCAN_CHUNKED 2
#endif
typedef short sc_bf16x8 __attribute__((ext_vector_type(8)));
constexpr int SC_LDL = 72, SC_LDJ = 40;
__device__ __forceinline__ sc_bf16x8 sc_frag(const bf16* base, int ld, int row, int k0) { return *(const sc_bf16x8*)(base + row * ld + k0); }
__device__ __forceinline__ void ph_scan_chunk(const Ctx& C, int l) {
    bf16* At = (bf16*)C.lds; bf16* Bt = At + 16 * SC_LDL; bf16* Kt = Bt + 16 * SC_LDL; bf16* Rt = Kt + 16 * SC_LDL;
    bf16* BhT = Rt + 16 * SC_LDL; bf16* KhT = BhT + 64 * SC_LDJ; bf16* Vt = KhT + 64 * SC_LDJ; bf16* Pt = Vt + 64 * SC_LDJ; bf16* Ut = Pt + 64 * SC_LDJ;
    bf16* Mak = Ut + 64 * SC_LDJ; bf16* Nrb = Mak + 16 * SC_LDJ; bf16* Nrk = Nrb + 16 * SC_LDJ; bf16* Tb = Nrk + 16 * SC_LDJ;
    bf16* Sb = Tb + 16 * SC_LDJ;
    float* Mf = (float*)(Sb + 64 * SC_LDL); float* lw = Mf + 16 * 17; float* gc = lw + 16 * 64;
    const bf16* rkv = (const bf16*)(C.ws + WS_RKV); const _Float16* lr = (const _Float16*)(C.ws + WS_LR); bf16* ydir = (bf16*)(C.ws + WS_Y2);
    const int tid = opaque_tid(C.wave_s), lane = tid & 63, wv = __builtin_amdgcn_readfirstlane(tid >> 6), ss = tid >> 5, cp = tid & 31;
    const int fr = lane & 15, fq = lane >> 4;
    for (int it = blockIdx.x; it < 256; it += gridDim.x) {
        const int b = it >> 5, h = (it >> 1) & 15, dir = it & 1, ch = h * 64 + 2 * cp;
        const float kks0 = C.inp(I_KK)[l * BW + ch], kks1 = C.inp(I_KK)[l * BW + ch + 1], ka0 = C.inp(I_KA)[l * BW + ch], ka1 = C.inp(I_KA)[l * BW + ch + 1];
        const float dw0 = C.inp(I_DW0)[(l * 2 + dir) * BW + ch], dw1 = C.inp(I_DW0)[(l * 2 + dir) * BW + ch + 1], ia0 = C.inp(I_A0)[(l * 2 + dir) * BW + ch], ia1 = C.inp(I_A0)[(l * 2 + dir) * BW + ch + 1];
        for (int i = tid; i < (int)((char*)Mf - (char*)BhT) / 4; i += NTHR) ((unsigned*)BhT)[i] = 0u;
        f32x4 S0 = (f32x4){0.f, 0.f, 0.f, 0.f}, S1 = S0;
        unsigned rr, rk, rv; h2 rs, ra;
#define SCAN_ROW(g) ((g) < 256 ? (ML + b * 256 + (dir ? 255 - (g) : (g))) : (b * 4096 + (dir ? 4095 - ((g) - 256) : ((g) - 256))))
#define SCAN_LOAD(c) do { const size_t _row = (size_t)SCAN_ROW(16 * (c) + ss); rr = *(const unsigned*)(rkv + _row * 3072 + ch); rk = *(const unsigned*)(rkv + _row * 3072 + 1024 + ch); rv = *(const unsigned*)(rkv + _row * 3072 + 2048 + ch); \
        rs = *(const h2*)(lr + _row * NLR + dir * 1024 + ch); ra = *(const h2*)(lr + _row * NLR + 2048 + dir * 1024 + ch); } while (0)
        SCAN_LOAD(0);
        WG_BAR_LDS();
        for (int c = 0; c < 272; ++c) {
            const float k0 = bflo(rk), k1 = bfhi(rk), q0 = k0 * kks0, q1 = k1 * kks1; float sq = q0 * q0 + q1 * q1;
#pragma unroll
            for (int o = 1; o < 32; o <<= 1) sq += __shfl_xor(sq, o);
            const float inv = __builtin_amdgcn_rsqf(fmaxf(sq, 1e-24f)), n0 = q0 * inv, n1 = q1 * inv;
            const float a0 = fsigmoid((float)ra[0] + ia0), a1 = fsigmoid((float)ra[1] + ia1), sd0 = fsigmoid((float)rs[0] + dw0), sd1 = fsigmoid((float)rs[1] + dw1);
            const float kd0 = k0 * (1.f + (a0 - 1.f) * ka0), kd1 = k1 * (1.f + (a1 - 1.f) * ka1), r0 = bflo(rr), r1 = bfhi(rr), v0 = bflo(rv), v1 = bfhi(rv);
            *(f32x2v*)(lw + ss * 64 + 2 * cp) = (f32x2v){-0.60653065971f * sd0, -0.60653065971f * sd1};
            if (c + 1 < 272) SCAN_LOAD(c + 1);
            WG_BAR_LDS();
            if (tid < 64) { float run = 0.f;
                float t[16];
#pragma unroll
                for (int s2 = 0; s2 < 16; ++s2) t[s2] = lw[s2 * 64 + tid];
#pragma unroll
                for (int s2 = 0; s2 < 16; ++s2) { run += t[s2]; lw[s2 * 64 + tid] = run; } }
            WG_BAR_LDS();
            { const f32x2v cum = *(const f32x2v*)(lw + ss * 64 + 2 * cp), c15 = *(const f32x2v*)(lw + 15 * 64 + 2 * cp);
              f32x2v cpr = (f32x2v){0.f, 0.f}; if (ss > 0) cpr = *(const f32x2v*)(lw + (ss - 1) * 64 + 2 * cp);
              const float G0 = __expf(cum.x), G1 = __expf(cum.y), P0 = __expf(cpr.x), P1 = __expf(cpr.y), I0 = __expf(-cum.x), I1 = __expf(-cum.y), E0 = __expf(c15.x - cum.x), E1 = __expf(c15.y - cum.y);
              *(unsigned*)(At + ss * SC_LDL + 2 * cp) = pk2(-n0 * P0, -n1 * P1);
              *(unsigned*)(Bt + ss * SC_LDL + 2 * cp) = pk2(n0 * a0 * I0, n1 * a1 * I1);
              *(unsigned*)(Kt + ss * SC_LDL + 2 * cp) = pk2(kd0 * I0, kd1 * I1);
              *(unsigned*)(Rt + ss * SC_LDL + 2 * cp) = pk2(r0 * G0, r1 * G1);
              BhT[(2 * cp) * SC_LDJ + ss] = (bf16)f2bf(n0 * a0 * E0); BhT[(2 * cp + 1) * SC_LDJ + ss] = (bf16)f2bf(n1 * a1 * E1);
              KhT[(2 * cp) * SC_LDJ + ss] = (bf16)f2bf(kd0 * E0);      KhT[(2 * cp + 1) * SC_LDJ + ss] = (bf16)f2bf(kd1 * E1);
              Vt[(2 * cp) * SC_LDJ + ss] = (bf16)f2bf(v0);             Vt[(2 * cp + 1) * SC_LDJ + ss] = (bf16)f2bf(v1);
              if (ss == 15) *(f32x2v*)(gc + 2 * cp) = (f32x2v){__expf(c15.x), __expf(c15.y)}; }
            WG_BAR_LDS();
            f32x4 accP = (f32x4){0.f, 0.f, 0.f, 0.f}, accY = accP;
            if (wv < 4) { const bf16* X = (wv < 2) ? At : Rt; const bf16* Y = (wv & 1) ? Kt : Bt; f32x4 m = (f32x4){0.f, 0.f, 0.f, 0.f};
#pragma unroll
                for (int ks = 0; ks < 2; ++ks) m = __builtin_amdgcn_mfma_f32_16x16x32_bf16(sc_frag(X, SC_LDL, fr, 32 * ks + 8 * fq), sc_frag(Y, SC_LDL, fr, 32 * ks + 8 * fq), m, 0, 0, 0);
#pragma unroll
                for (int e = 0; e < 4; ++e) { const int i = 4 * fq + e; const bool keep = (wv < 2) ? (fr < i) : (fr <= i); const float val = keep ? m[e] : 0.f;
                    if (wv == 0) Mf[i * 17 + fr] = val; else ((wv == 1) ? Mak : (wv == 2) ? Nrb : Nrk)[i * SC_LDJ + fr] = (bf16)f2bf(val); }
            } else { const int tv = wv - 4;
#pragma unroll
                for (int ks = 0; ks < 2; ++ks) { const sc_bf16x8 sb = sc_frag(Sb, SC_LDL, 16 * tv + fr, 32 * ks + 8 * fq);
                    accP = __builtin_amdgcn_mfma_f32_16x16x32_bf16(sc_frag(At, SC_LDL, fr, 32 * ks + 8 * fq), sb, accP, 0, 0, 0);
                    accY = __builtin_amdgcn_mfma_f32_16x16x32_bf16(sc_frag(Rt, SC_LDL, fr, 32 * ks + 8 * fq), sb, accY, 0, 0, 0); } }
            WG_BAR_LDS();
            if (wv >= 4) { const int tv = wv - 4; const sc_bf16x8 vb = sc_frag(Vt, SC_LDJ, 16 * tv + fr, 8 * fq);
                accP = __builtin_amdgcn_mfma_f32_16x16x32_bf16(sc_frag(Mak, SC_LDJ, fr, 8 * fq), vb, accP, 0, 0, 0);
                accY = __builtin_amdgcn_mfma_f32_16x16x32_bf16(sc_frag(Nrk, SC_LDJ, fr, 8 * fq), vb, accY, 0, 0, 0);
                float* Pf = (float*)Pt + tv * (16 * 17);
#pragma unroll
                for (int e = 0; e < 4; ++e) Pf[fr * 17 + 4 * fq + e] = accP[e];
                float mrow[16];
#pragma unroll
                for (int i = 0; i < 16; ++i) mrow[i] = Mf[i * 17 + fr];
                LDS_WAIT();
                float u[16];
#pragma unroll
                for (int i = 0; i < 16; ++i) { float acc = Pf[fr * 17 + i];
#pragma unroll
                    for (int jj = 0; jj < i; ++jj) acc += __builtin_bit_cast(float, __builtin_amdgcn_readlane(__builtin_bit_cast(int, mrow[i]), jj)) * u[jj];
                    u[i] = acc; }
                if (fq == 0) {
#pragma unroll
                    for (int i = 0; i < 16; i += 2) *(unsigned*)(Ut + (16 * tv + fr) * SC_LDJ + i) = pk2(u[i], u[i + 1]); }
                LDS_WAIT();
                accY = __builtin_amdgcn_mfma_f32_16x16x32_bf16(sc_frag(Nrb, SC_LDJ, fr, 8 * fq), sc_frag(Ut, SC_LDJ, 16 * tv + fr, 8 * fq), accY, 0, 0, 0);
#pragma unroll
                for (int e = 0; e < 4; ++e) { const size_t row = (size_t)SCAN_ROW(16 * c + 4 * fq + e);
                    ydir[((size_t)dir * MT + row) * BW + h * 64 + 16 * tv + fr] = (bf16)f2bf(accY[e]); } }
            WG_BAR_LDS();
            { const int tv = wv >> 1, tk = 2 * (wv & 1);
              const sc_bf16x8 ua = sc_frag(Ut, SC_LDJ, 16 * tv + fr, 8 * fq), va = sc_frag(Vt, SC_LDJ, 16 * tv + fr, 8 * fq);
              const float g0 = gc[16 * tk + fr], g1 = gc[16 * (tk + 1) + fr];
              S0 = S0 * g0; S1 = S1 * g1;
              S0 = __builtin_amdgcn_mfma_f32_16x16x32_bf16(ua, sc_frag(BhT, SC_LDJ, 16 * tk + fr, 8 * fq), S0, 0, 0, 0);
              S0 = __builtin_amdgcn_mfma_f32_16x16x32_bf16(va, sc_frag(KhT, SC_LDJ, 16 * tk + fr, 8 * fq), S0, 0, 0, 0);
              S1 = __builtin_amdgcn_mfma_f32_16x16x32_bf16(ua, sc_frag(BhT, SC_LDJ, 16 * (tk + 1) + fr, 8 * fq), S1, 0, 0, 0);
              S1 = __builtin_amdgcn_mfma_f32_16x16x32_bf16(va, sc_frag(KhT, SC_LDJ, 16 * (tk + 1) + fr, 8 * fq), S1, 0, 0, 0);
#pragma unroll
              for (int e = 0; e < 4; ++e) { Sb[(16 * tv + 4 * fq + e) * SC_LDL + 16 * tk + fr] = (bf16)f2bf(S0[e]); Sb[(16 * tv + 4 * fq + e) * SC_LDL + 16 * (tk + 1) + fr] = (bf16)f2bf(S1[e]); } }
            WG_BAR_LDS();
        }
#undef SCAN_LOAD
#undef SCAN_ROW
    }
}

typedef _Float16 h4 __attribute__((ext_vector_type(4)));
struct __attribute__((aligned(8))) u32x2 { unsigned x, y; };
#define DPP_F(x, ctrl) __builtin_bit_cast(float, __builtin_amdgcn_update_dpp(0, __builtin_bit_cast(int, (x)), (ctrl), 0xF, 0xF, true))
constexpr int WSO_BYTES = 4 * 16 * SC_LDL * 2 + 3 * 64 * SC_LDJ * 2 + 256;
constexpr int WSX_BYTES = 16 * 17 * 4 + 3 * 16 * SC_LDJ * 2;
constexpr int WSC_BYTES = 16 * SC_LDL * 2 + 16 * 20 * 4 + 16 * SC_LDJ * 2;
constexpr int WS_SCAN_LDS = 3 * WSO_BYTES + 2 * WSX_BYTES + 4 * WSC_BYTES;
static_assert(WS_SCAN_LDS + 256 <= RING_BYTES && WSO_BYTES % 16 == 0 && WSX_BYTES % 16 == 0 && WSC_BYTES % 16 == 0, "scan LDS carve");
__device__ __forceinline__ void ph_scan_ws(const Ctx& C, int l) {
    unsigned char* const L = C.lds; float* const kkt = (float*)(L + WS_SCAN_LDS);
    const bf16* rkv = (const bf16*)(C.ws + WS_RKV); const _Float16* lr = (const _Float16*)(C.ws + WS_LR); bf16* ydir = (bf16*)(C.ws + WS_Y2);
    const int tid = opaque_tid(C.wave_s), lane = tid & 63, wv = __builtin_amdgcn_readfirstlane(tid >> 6);
    const int fr = lane & 15, fq = lane >> 4;
    for (int it = blockIdx.x; it < 256; it += gridDim.x) {
        const int b = it >> 5, h = (it >> 1) & 15, dir = it & 1;
        for (int i = tid; i < WS_SCAN_LDS / 4; i += NTHR) ((unsigned*)L)[i] = 0u;
        if (tid < 64) kkt[tid] = C.inp(I_KK)[l * BW + h * 64 + tid];
        WG_BAR_LDS();
#define SCAN_ROW(g) ((g) < 256 ? (ML + b * 256 + (dir ? 255 - (g) : (g))) : (b * 4096 + (dir ? 4095 - ((g) - 256) : ((g) - 256))))
        if (wv < 4) {
            const int cl = 16 * wv + 4 * fq, c0 = h * 64 + cl;
            float kko[4], kav[4], dwv[4], iav[4], kkn[16];
#pragma unroll
            for (int j = 0; j < 4; ++j) { kko[j] = kkt[cl + j]; kav[j] = C.inp(I_KA)[l * BW + c0 + j]; dwv[j] = C.inp(I_DW0)[(l * 2 + dir) * BW + c0 + j]; iav[j] = C.inp(I_A0)[(l * 2 + dir) * BW + c0 + j]; }
#pragma unroll
            for (int j = 0; j < 16; ++j) kkn[j] = kkt[16 * fq + j];
            struct Raw { u32x2 rr, rk, rv; h4 rs, ra; v4u kn0, kn1; } RA, RB;
#define WS_LOAD(R, c) do { const size_t _row = (size_t)SCAN_ROW(16 * (c) + fr); const bf16* _p = rkv + _row * 3072 + c0; R.rr = *(const u32x2*)_p; R.rk = *(const u32x2*)(_p + 1024); R.rv = *(const u32x2*)(_p + 2048); \
            R.rs = *(const h4*)(lr + _row * NLR + dir * 1024 + c0); R.ra = *(const h4*)(lr + _row * NLR + 2048 + dir * 1024 + c0); \
            R.kn0 = *(const v4u*)(rkv + _row * 3072 + 1024 + h * 64 + 16 * fq); R.kn1 = *(const v4u*)(rkv + _row * 3072 + 1024 + h * 64 + 16 * fq + 8); } while (0)
            WS_LOAD(RA, 0); WS_LOAD(RB, 1);
            __builtin_amdgcn_s_setprio(2);
            auto stage = [&](const int t, Raw& R, const int Q3) __attribute__((always_inline)) {
                {
                    unsigned char* O = L + Q3 * WSO_BYTES;
                    bf16* At = (bf16*)O; bf16* Bt = At + 16 * SC_LDL; bf16* Kt = Bt + 16 * SC_LDL; bf16* Rt = Kt + 16 * SC_LDL;
                    bf16* BhT = Rt + 16 * SC_LDL; bf16* KhT = BhT + 64 * SC_LDJ; bf16* Vt = KhT + 64 * SC_LDJ; float* gc = (float*)(Vt + 64 * SC_LDJ);
                    const float kf[4] = {bflo(R.rk.x), bfhi(R.rk.x), bflo(R.rk.y), bfhi(R.rk.y)}, rf[4] = {bflo(R.rr.x), bfhi(R.rr.x), bflo(R.rr.y), bfhi(R.rr.y)};
                    const unsigned vb0 = R.rv.x, vb1 = R.rv.y;
                    const unsigned knu[8] = {R.kn0.x, R.kn0.y, R.kn0.z, R.kn0.w, R.kn1.x, R.kn1.y, R.kn1.z, R.kn1.w};
                    f32x2v sq2 = (f32x2v){0.f, 0.f};
#pragma unroll
                    for (int j = 0; j < 8; ++j) { const f32x2v x = (f32x2v){bflo(knu[j]), bfhi(knu[j])} * (f32x2v){kkn[2 * j], kkn[2 * j + 1]}; sq2 += x * x; }
                    float sq = sq2.x + sq2.y;
                    sq += __shfl_xor(sq, 16); sq += __shfl_xor(sq, 32);
                    const float inv = __builtin_amdgcn_rsqf(fmaxf(sq, 1e-24f));
                    float nn[4], aa[4], kd[4], lwv[4];
#pragma unroll
                    for (int j = 0; j < 4; ++j) { nn[j] = kf[j] * kko[j] * inv; aa[j] = fsigmoid((float)R.ra[j] + iav[j]); const float sd = fsigmoid((float)R.rs[j] + dwv[j]);
                        kd[j] = kf[j] * (1.f + (aa[j] - 1.f) * kav[j]); lwv[j] = -0.60653065971f * sd; }
                    { const int tn = (t + 2 < 272) ? t + 2 : 271; WS_LOAD(R, tn); }
                    float at[4], bt[4], kt[4], rt[4], bh[4], kh[4], gt[4];
#pragma unroll
                    for (int j = 0; j < 4; ++j) {
                        float cum = lwv[j]; cum += DPP_F(cum, 0x111); cum += DPP_F(cum, 0x112); cum += DPP_F(cum, 0x114); cum += DPP_F(cum, 0x118);
                        const float tot = __builtin_bit_cast(float, __builtin_amdgcn_ds_swizzle(__builtin_bit_cast(int, cum), 0x1F0));
                        const float G = __expf(cum), GT = __expf(tot), I = __builtin_amdgcn_rcpf(G), E = GT * I;
                        const float P = __builtin_bit_cast(float, __builtin_amdgcn_update_dpp(0x3f800000, __builtin_bit_cast(int, G), 0x111, 0xF, 0xF, false));
                        const float na = nn[j] * aa[j];
                        at[j] = -nn[j] * P; bt[j] = na * I; kt[j] = kd[j] * I; rt[j] = rf[j] * G; bh[j] = na * E; kh[j] = kd[j] * E; gt[j] = GT; }
                    *(u32x2*)(At + fr * SC_LDL + cl) = (u32x2){pg8::cvt_pk_bf16(at[0], at[1]), pg8::cvt_pk_bf16(at[2], at[3])};
                    *(u32x2*)(Bt + fr * SC_LDL + cl) = (u32x2){pg8::cvt_pk_bf16(bt[0], bt[1]), pg8::cvt_pk_bf16(bt[2], bt[3])};
                    *(u32x2*)(Kt + fr * SC_LDL + cl) = (u32x2){pg8::cvt_pk_bf16(kt[0], kt[1]), pg8::cvt_pk_bf16(kt[2], kt[3])};
                    *(u32x2*)(Rt + fr * SC_LDL + cl) = (u32x2){pg8::cvt_pk_bf16(rt[0], rt[1]), pg8::cvt_pk_bf16(rt[2], rt[3])};
#pragma unroll
                    for (int j = 0; j < 4; j += 2) { const unsigned pb = pg8::cvt_pk_bf16(bh[j], bh[j + 1]), pk = pg8::cvt_pk_bf16(kh[j], kh[j + 1]);
                        BhT[(cl + j) * SC_LDJ + fr] = (bf16)(pb & 0xffffu); BhT[(cl + j + 1) * SC_LDJ + fr] = (bf16)(pb >> 16);
                        KhT[(cl + j) * SC_LDJ + fr] = (bf16)(pk & 0xffffu); KhT[(cl + j + 1) * SC_LDJ + fr] = (bf16)(pk >> 16); }
                    Vt[(cl + 0) * SC_LDJ + fr] = (bf16)(vb0 & 0xffffu); Vt[(cl + 1) * SC_LDJ + fr] = (bf16)(vb0 >> 16);
                    Vt[(cl + 2) * SC_LDJ + fr] = (bf16)(vb1 & 0xffffu); Vt[(cl + 3) * SC_LDJ + fr] = (bf16)(vb1 >> 16);
                    if (fr == 15) *(f32x4*)(gc + cl) = (f32x4){gt[0], gt[1], gt[2], gt[3]};
                }
            };
            auto mats = [&](const int Q3P, const int PAR) __attribute__((always_inline)) {
                {
                    unsigned char* O = L + Q3P * WSO_BYTES; unsigned char* X = L + 3 * WSO_BYTES + PAR * WSX_BYTES;
                    const bf16* At = (const bf16*)O; const bf16* Bt = At + 16 * SC_LDL; const bf16* Kt = Bt + 16 * SC_LDL; const bf16* Rt = Kt + 16 * SC_LDL;
                    float* Mf = (float*)X; bf16* Mak = (bf16*)(X + 16 * 17 * 4); bf16* Nrb = Mak + 16 * SC_LDJ; bf16* Nrk = Nrb + 16 * SC_LDJ;
                    const bf16* Xo = (wv < 2) ? At : Rt; const bf16* Yo = (wv & 1) ? Kt : Bt; f32x4 m = (f32x4){0.f, 0.f, 0.f, 0.f};
#pragma unroll
                    for (int ks = 0; ks < 2; ++ks) m = __builtin_amdgcn_mfma_f32_16x16x32_bf16(sc_frag(Xo, SC_LDL, fr, 32 * ks + 8 * fq), sc_frag(Yo, SC_LDL, fr, 32 * ks + 8 * fq), m, 0, 0, 0);
#pragma unroll
                    for (int e = 0; e < 4; ++e) { const int i = 4 * fq + e; const bool keep = (wv < 2) ? (fr < i) : (fr <= i); m[e] = keep ? m[e] : 0.f; }
                    if (wv == 0) {
                        *(f32x2v*)(Mf + ((2 * fq) * 16 + fr) * 2) = (f32x2v){m[0], m[1]}; *(f32x2v*)(Mf + ((2 * fq + 1) * 16 + fr) * 2) = (f32x2v){m[2], m[3]};
                    } else { bf16* Mo = (wv == 1) ? Mak : (wv == 2) ? Nrb : Nrk; const unsigned p01 = pg8::cvt_pk_bf16(m[0], m[1]), p23 = pg8::cvt_pk_bf16(m[2], m[3]);
                        Mo[(4 * fq + 0) * SC_LDJ + fr] = (bf16)(p01 & 0xffffu); Mo[(4 * fq + 1) * SC_LDJ + fr] = (bf16)(p01 >> 16);
                        Mo[(4 * fq + 2) * SC_LDJ + fr] = (bf16)(p23 & 0xffffu); Mo[(4 * fq + 3) * SC_LDJ + fr] = (bf16)(p23 >> 16); }
                }
            };
            stage(0, RA, 0); WG_BAR_LDS();
            stage(1, RB, 1); mats(0, 0); WG_BAR_LDS();
            for (int tb = 2; tb < 272; tb += 6) {
#pragma unroll
                for (int k = 0; k < 6; ++k) { if (k & 1) stage(tb + k, RB, (2 + k) % 3); else stage(tb + k, RA, (2 + k) % 3);
                    mats((1 + k) % 3, (1 + k) & 1); WG_BAR_LDS(); } }
            mats(271 % 3, 271 & 1); WG_BAR_LDS();
            WG_BAR_LDS();
            __builtin_amdgcn_s_setprio(0);
#undef WS_LOAD
        } else {
            const int tv = wv - 4;
            unsigned char* Pv = L + 3 * WSO_BYTES + 2 * WSX_BYTES + tv * WSC_BYTES;
            bf16* Sbw = (bf16*)Pv; float* Pfw = (float*)(Pv + 16 * SC_LDL * 2); bf16* Utw = (bf16*)(Pv + 16 * SC_LDL * 2 + 16 * 20 * 4);
            f32x4 S[4];
#pragma unroll
            for (int tk = 0; tk < 4; ++tk) S[tk] = (f32x4){0.f, 0.f, 0.f, 0.f};
            __builtin_amdgcn_s_waitcnt(0x0F70);
            auto cons = [&](const int t, const int Q3, const int PAR) __attribute__((always_inline)) {
                { const int c = t - 2;
                    unsigned char* O = L + Q3 * WSO_BYTES; unsigned char* X = L + 3 * WSO_BYTES + PAR * WSX_BYTES;
                    const bf16* At = (const bf16*)O; const bf16* Rt = At + 3 * 16 * SC_LDL;
                    const bf16* BhT = Rt + 16 * SC_LDL; const bf16* KhT = BhT + 64 * SC_LDJ; const bf16* Vt = KhT + 64 * SC_LDJ; const float* gc = (const float*)(Vt + 64 * SC_LDJ);
                    const float* Mf = (const float*)X; const bf16* Mak = (const bf16*)(X + 16 * 17 * 4); const bf16* Nrb = Mak + 16 * SC_LDJ; const bf16* Nrk = Nrb + 16 * SC_LDJ;
                    const sc_bf16x8 sb0 = sc_frag(Sbw, SC_LDL, fr, 8 * fq), sb1 = sc_frag(Sbw, SC_LDL, fr, 32 + 8 * fq);
                    const sc_bf16x8 at0 = sc_frag(At, SC_LDL, fr, 8 * fq), at1 = sc_frag(At, SC_LDL, fr, 32 + 8 * fq), rt0 = sc_frag(Rt, SC_LDL, fr, 8 * fq), rt1 = sc_frag(Rt, SC_LDL, fr, 32 + 8 * fq);
                    const sc_bf16x8 vb = sc_frag(Vt, SC_LDJ, 16 * tv + fr, 8 * fq), mak = sc_frag(Mak, SC_LDJ, fr, 8 * fq), nrk = sc_frag(Nrk, SC_LDJ, fr, 8 * fq), nrb = sc_frag(Nrb, SC_LDJ, fr, 8 * fq);
                    f32x4 mm[28]; f32x2v md[8];
#pragma unroll
                    for (int ip = 0; ip < 5; ++ip) {
#pragma unroll
                        for (int jj = 0; jj < ip; ++jj) mm[ip * (ip - 1) / 2 + jj] = *(const f32x4*)(Mf + (ip * 16 + 2 * jj) * 2);
                        md[ip] = *(const f32x2v*)(Mf + (ip * 16 + 2 * ip) * 2); }
                    __builtin_amdgcn_sched_barrier(0);
                    const f32x4 z4 = (f32x4){0.f, 0.f, 0.f, 0.f};
                    f32x4 accP = __builtin_amdgcn_mfma_f32_16x16x32_bf16(at0, sb0, z4, 0, 0, 0), accY = __builtin_amdgcn_mfma_f32_16x16x32_bf16(rt0, sb0, z4, 0, 0, 0);
                    accP = __builtin_amdgcn_mfma_f32_16x16x32_bf16(at1, sb1, accP, 0, 0, 0); accY = __builtin_amdgcn_mfma_f32_16x16x32_bf16(rt1, sb1, accY, 0, 0, 0);
                    accP = __builtin_amdgcn_mfma_f32_16x16x32_bf16(mak, vb, accP, 0, 0, 0);  accY = __builtin_amdgcn_mfma_f32_16x16x32_bf16(nrk, vb, accY, 0, 0, 0);
#pragma unroll
                    for (int ip = 5; ip < 8; ++ip) {
#pragma unroll
                        for (int jj = 0; jj < ip; ++jj) mm[ip * (ip - 1) / 2 + jj] = *(const f32x4*)(Mf + (ip * 16 + 2 * jj) * 2);
                        md[ip] = *(const f32x2v*)(Mf + (ip * 16 + 2 * ip) * 2); }
                    __builtin_amdgcn_sched_barrier(0);
                    *(f32x4*)(Pfw + fr * 20 + 4 * fq) = accP;
                    f32x4 pq[4];
#pragma unroll
                    for (int q = 0; q < 4; ++q) pq[q] = *(const f32x4*)(Pfw + fr * 20 + 4 * q);
                    float u[16];
#define WS_SUBST(ip) do { f32x2v acc = (f32x2v){pq[(ip) >> 1][2 * ((ip) & 1)], pq[(ip) >> 1][2 * ((ip) & 1) + 1]};   \
                        _Pragma("unroll") for (int jj = 0; jj < (ip); ++jj) { const f32x4 m4 = mm[(ip) * ((ip) - 1) / 2 + jj]; \
                            acc += (f32x2v){m4.x, m4.y} * (f32x2v){u[2 * jj], u[2 * jj]}; acc += (f32x2v){m4.z, m4.w} * (f32x2v){u[2 * jj + 1], u[2 * jj + 1]}; } \
                        u[2 * (ip)] = acc.x; u[2 * (ip) + 1] = acc.y + md[ip].y * acc.x; } while (0)
                    WS_SUBST(0); WS_SUBST(1); WS_SUBST(2); WS_SUBST(3); WS_SUBST(4);
                    sc_bf16x8 bh[4], kh[4]; float gcv[4];
#pragma unroll
                    for (int tk = 0; tk < 4; ++tk) { bh[tk] = sc_frag(BhT, SC_LDJ, 16 * tk + fr, 8 * fq); kh[tk] = sc_frag(KhT, SC_LDJ, 16 * tk + fr, 8 * fq); gcv[tk] = gc[16 * tk + fr]; }
                    __builtin_amdgcn_sched_barrier(0);
                    WS_SUBST(5); WS_SUBST(6); WS_SUBST(7);
#undef WS_SUBST
                    v4u uw;
#pragma unroll
                    for (int q = 0; q < 4; ++q) { const unsigned lo = pg8::cvt_pk_bf16(u[2 * q], u[2 * q + 1]), hi = pg8::cvt_pk_bf16(u[8 + 2 * q], u[8 + 2 * q + 1]); uw[q] = (fq == 0) ? lo : (fq == 1) ? hi : 0u; }
                    const sc_bf16x8 ua = __builtin_bit_cast(sc_bf16x8, uw);
                    accY = __builtin_amdgcn_mfma_f32_16x16x32_bf16(nrb, ua, accY, 0, 0, 0);
#pragma unroll
                    for (int e = 0; e < 4; e += 2) { const unsigned py = pg8::cvt_pk_bf16(accY[e], accY[e + 1]);
                        ydir[((size_t)dir * MT + (size_t)SCAN_ROW(16 * c + 4 * fq + e)) * BW + h * 64 + 16 * tv + fr] = (bf16)(py & 0xffffu);
                        ydir[((size_t)dir * MT + (size_t)SCAN_ROW(16 * c + 4 * fq + e + 1)) * BW + h * 64 + 16 * tv + fr] = (bf16)(py >> 16); }
#pragma unroll
                    for (int tk = 0; tk < 4; ++tk) {
                        S[tk] = S[tk] * gcv[tk];
                        S[tk] = __builtin_amdgcn_mfma_f32_16x16x32_bf16(ua, bh[tk], S[tk], 0, 0, 0);
                        S[tk] = __builtin_amdgcn_mfma_f32_16x16x32_bf16(vb, kh[tk], S[tk], 0, 0, 0); }
#pragma unroll
                    for (int tk = 0; tk < 4; ++tk) {
#pragma unroll
                        for (int e = 0; e < 4; e += 2) { const unsigned ps = pg8::cvt_pk_bf16(S[tk][e], S[tk][e + 1]);
                            Sbw[(4 * fq + e) * SC_LDL + 16 * tk + fr] = (bf16)(ps & 0xffffu); Sbw[(4 * fq + e + 1) * SC_LDL + 16 * tk + fr] = (bf16)(ps >> 16); } }
                }
            };
            WG_BAR_LDS(); WG_BAR_LDS();
            { int q3 = 0;
#pragma nounroll
              for (int t = 2; t < 274; ++t) { cons(t, q3, t & 1); q3 = (q3 == 2) ? 0 : q3 + 1; WG_BAR_LDS(); } }
        }
#undef SCAN_ROW
    }
}

__device__ __forceinline__ void ph_rwkvout(const Ctx& C, int l, int Mrows) {
    const int tid = opaque_tid(C.wave_s), lane = tid & 63, wave = __builtin_amdgcn_readfirstlane(tid >> 6), cG = opaque_s(C.G), cvcu = opaque_s(C.vcu); (void)lane; (void)wave; (void)cG; (void)cvcu;

    const int gw = cvcu * NWAVES + wave, NGW = cG * NWAVES;
    const bf16* rkv = (const bf16*)(C.ws + WS_RKV); const _Float16* lr = (const _Float16*)(C.ws + WS_LR); const bf16* ydir = (const bf16*)(C.ws + WS_Y2); bf16* ya = (bf16*)(C.ws + WS_YA);
    for (int m = gw; m < Mrows; m += NGW) {
#pragma unroll
        for (int hp = 0; hp < 8; ++hp) { const int col = hp * 128 + 2 * lane;
            const unsigned wr = *(const unsigned*)(rkv + (size_t)m * 3072 + col), wk = *(const unsigned*)(rkv + (size_t)m * 3072 + 1024 + col), wvv = *(const unsigned*)(rkv + (size_t)m * 3072 + 2048 + col);
            const unsigned yf = *(const unsigned*)(ydir + (size_t)m * BW + col), ybk = *(const unsigned*)(ydir + ((size_t)MT + m) * BW + col);
            const h2 p0 = *(const h2*)(lr + (size_t)m * NLR + 2048 + col), p1 = *(const h2*)(lr + (size_t)m * NLR + 3072 + col), gg = *(const h2*)(lr + (size_t)m * NLR + 4096 + col);
            const f32x2v b0 = *(const f32x2v*)(C.inp(I_A0) + (l * 2 + 0) * BW + col), b1 = *(const f32x2v*)(C.inp(I_A0) + (l * 2 + 1) * BW + col);
            const f32x2v a0 = (f32x2v){fsigmoid((float)p0[0] + b0.x), fsigmoid((float)p0[1] + b0.y)}, a1 = (f32x2v){fsigmoid((float)p1[0] + b1.x), fsigmoid((float)p1[1] + b1.y)};
            const f32x2v ka = *(const f32x2v*)(C.inp(I_KA) + l * BW + col), rk = *(const f32x2v*)(C.inp(I_RK) + l * BW + col), lw = *(const f32x2v*)(C.inp(I_LNW) + l * BW + col), lb = *(const f32x2v*)(C.inp(I_LNB) + l * BW + col);
            const float y0 = bflo(yf) + bflo(ybk), y1 = bfhi(yf) + bfhi(ybk);
            float s1 = y0 + y1;
            float bon = bflo(wr) * rk.x * bflo(wk) * (2.f + (a0.x + a1.x - 2.f) * ka.x) + bfhi(wr) * rk.y * bfhi(wk) * (2.f + (a0.y + a1.y - 2.f) * ka.y);
#pragma unroll
            for (int o = 1; o < 32; o <<= 1) { s1 += __shfl_xor(s1, o); bon += __shfl_xor(bon, o); }
            const float mu = s1 * (1.f / 64.f), e0 = y0 - mu, e1 = y1 - mu; float s2 = e0 * e0 + e1 * e1;
#pragma unroll
            for (int o = 1; o < 32; o <<= 1) s2 += __shfl_xor(s2, o);
            const float rstd = rsqrtf(s2 * (1.f / 64.f) + 64e-5f);
            const float o0 = ((e0 * rstd) * lw.x + lb.x + bon * bflo(wvv)) * (float)gg[0], o1 = ((e1 * rstd) * lw.y + lb.y + bon * bfhi(wvv)) * (float)gg[1];
            *(unsigned*)(ya + (size_t)m * BW + col) = pk2(o0, o1); }
    }
}

__device__ __forceinline__ void ph_attn(const Ctx& C, int l, bool ctx_out) {
    const att::bf16* Z2 = (const att::bf16*)(C.ws + WS_Z); att::bf16* yc = (att::bf16*)(C.ws + WS_YC);
    float* tmp = (float*)(C.ws + WS_ATMP) + (size_t)blockIdx.x * 256 * 128;
    const float lam = ((const float*)(C.ws + WS_MISC))[2048 + l];
    const float lam_init = 0.8f - 0.6f * expf(-0.3f * (float)l);
    const float* subg = C.inp(I_SUBG) + l * 128;
    const int cG = opaque_s(C.G), cvcu = opaque_s(C.vcu);
    for (int i = 0;; ++i) {
        const int u = i * cG + cvcu;
        int qrow0, klat0, kctx0, nlat, NT, h;
        if (u < 1024) { const int b = u >> 7; h = (u >> 4) & 7; const int qb = u & 15; qrow0 = b * SEQ + qb * 256; klat0 = b * SEQ; kctx0 = ML + b * CTXL; nlat = 64; NT = 68; }
        else if (ctx_out && u < 1024 + 64) { const int uc = u - 1024, b = uc >> 3; h = uc & 7; qrow0 = ML + b * CTXL; klat0 = 0; kctx0 = ML + b * CTXL; nlat = 0; NT = 4; }
        else break;
        att::body<0>(Z2, qrow0, klat0, kctx0, nlat, NT, h * 128, 1024 + h * 128, 2048 + h * 128, tmp, nullptr, 0.f, subg, 0.f, (char*)C.lds, C.wave_s);
        att::body<1>(Z2, qrow0, klat0, kctx0, nlat, NT, h * 128 + 64, 1024 + h * 128 + 64, 2048 + h * 128, tmp, yc + (size_t)qrow0 * BW + h * 128, lam, subg, 1.f - lam_init, (char*)C.lds, C.wave_s);
    }
    __syncthreads();
}

__device__ __forceinline__ Ctx ctx_sub(const Ctx& C, int idx, int cnt) { Ctx c2 = C; c2.vcu = idx; c2.G = cnt; return c2; }

constexpr int PH_PER_LAYER = 12, N_PHASES = 1 + DEPTH * PH_PER_LAYER + 1;
struct Args { const float* in[N_IN]; float* out; unsigned char* ws; int ph_lo, ph_hi, bar_region, pad; };
template <unsigned KMASK> __device__ __forceinline__ void mk_body(const Args& args) {
    extern __shared__ __attribute__((aligned(16))) unsigned char lds[];
    Ctx C;
    C.lds = lds; C.wave_s = __builtin_amdgcn_readfirstlane((int)threadIdx.x >> 6);
    C.G = gridDim.x; { const int bx = blockIdx.x; C.vcu = (C.G % 8 == 0) ? (bx % 8) * (C.G / 8) + bx / 8 : bx; }
    C.ka = (const float* const __attribute__((address_space(4)))*)__builtin_amdgcn_kernarg_segment_ptr();
    C.out = args.out; C.ws = args.ws;
    LAS unsigned char* ldsl = (LAS unsigned char*)lds;
    for (int u = opaque_tid(C.wave_s); u < (LDS_BYTES - LDSCTL_OFF) / 4; u += NTHR) ((LAS unsigned*)(ldsl + LDSCTL_OFF))[u] = 0u;
    __syncthreads();
    const int lo = args.ph_lo, hi = args.ph_hi;
    const bool multi = (hi - lo) > 1;
    XcdBarrier bar; bar.bar = (unsigned*)(C.ws + WS_CTL) + CW_BAR + args.bar_region * XCD_BAR_WORDS; bar.x = 0; bar.st = nullptr;
    if (multi) bar = xcd_barrier_post((unsigned*)(C.ws + WS_CTL) + CW_BAR + args.bar_region * XCD_BAR_WORDS, (volatile LAS unsigned*)(ldsl + MISC_OFF) + 8, opaque_tid(C.wave_s) == 0);
#define IN(k) (lo <= (k) && (k) < hi)
#define EN(b) ((KMASK >> (b)) & 1u)
#define SEAM(k) do { if (IN((k) + 1)) xcd_barrier(bar, opaque_tid(C.wave_s) == 0); } while (0)
    using namespace pg8;
    bf16_t* const H = (bf16_t*)(C.ws + WS_H); bf16_t* const Z = (bf16_t*)(C.ws + WS_Z);
    float* const mods_all = (float*)(C.ws + WS_MODS);

    if (EN(0) && IN(0)) { ph_mods(C); SEAM(0); }
    for (int l = 0; l < DEPTH; ++l) {
        const int p0 = 1 + l * PH_PER_LAYER;
        if (hi <= p0 || lo >= p0 + PH_PER_LAYER) continue;
        const bool ctx_out = l < DEPTH - 1;
        const int Mx = ctx_out ? MT : ML;
        const float* mods_l = mods_all + (size_t)l * 9 * NMODC;
#define G opaque_s(C.G)
#define bid opaque_s((int)blockIdx.x)
        if (EN(1) && IN(p0 + 0)) { if (l == 0) ph_wprep(C, l); ph_norm(C, l, 0, MT); SEAM(p0 + 0); }
        if (EN(2) && IN(p0 + 1)) { Gemm g{H, (const bf16_t*)(C.ws + WSP(l) + WS_W1T), MT, N1, DM, DM}; StaticOrder S; S.init(MT, N1, G, bid, 4); EpiZ1 E{Z};
            gemm_phase<EpiZ1, StaticOrder, true, true>(ldsl, g, S, E, C.wave_s); SEAM(p0 + 1); }
        if (EN(3) && IN(p0 + 2)) { ph_convpool(C, l);
            Gemm g{Z + 3072, (const bf16_t*)(C.ws + WSP(l) + WS_WLRT), MT, NLR, KLR, N1};
            StaticOrder S; S.init(MT, NLR, G, bid, 4);
            EpiLr E{(_Float16*)(C.ws + WS_LR)};
            gemm_phase<EpiLr, StaticOrder, true, true>(ldsl, g, S, E, C.wave_s); SEAM(p0 + 2); }
        if (EN(4) && IN(p0 + 3)) { if (SCAN_CHUNKED == 2) ph_scan_ws(C, l); else if (SCAN_CHUNKED) ph_scan_chunk(C, l); else ph_scan(C, l); SEAM(p0 + 3); }
        if (EN(5) && IN(p0 + 4)) { ph_rwkvout(C, l, Mx);
            Gemm g{H, (const bf16_t*)(C.ws + WSP(l) + WS_W2T), MT, N2, DM, DM}; StaticOrder S; S.init(MT, N2, G, bid, 4); EpiZ2 E{Z, (const float*)(C.ws + WS_MISC), (const float*)(C.ws + WS_MISC) + 1024};
            gemm_phase<EpiZ2, StaticOrder, true, true>(ldsl, g, S, E, C.wave_s); SEAM(p0 + 4); }
        if (EN(6) && IN(p0 + 5)) { ph_attn(C, l, ctx_out); SEAM(p0 + 5); }
        if (EN(7) && IN(p0 + 6)) {
            Gemm g{H, (const bf16_t*)(C.ws + WSP(l) + WS_W3T), Mx, N3, DM, DM};
            StaticOrder S; S.init(Mx, N3, G, bid, 4);
            EpiGate E{Z};
            gemm_phase<EpiGate, StaticOrder, true, true>(ldsl, g, S, E, C.wave_s);
            SEAM(p0 + 6); }
        if (EN(8) && IN(p0 + 7)) { bf16_t* accb = (bf16_t*)(C.ws + WS_RKV); const bf16_t* WB = (const bf16_t*)(C.ws + WSP(l) + WS_WBT);
            StaticOrder S; S.init(Mx, DM, G, bid, 2);
            { Gemm g{(const bf16_t*)(C.ws + WS_YA), WB, Mx, DM, BW, BW}; EpiMerge<0> E{Z, accb}; gemm_phase<EpiMerge<0>, StaticOrder, true, true>(ldsl, g, S, E, C.wave_s); }
            { Gemm g{(const bf16_t*)(C.ws + WS_POOL), WB + (size_t)DM * BW, Mx, DM, BW, BW}; EpiMerge<1> E{Z, accb}; gemm_phase<EpiMerge<1>, StaticOrder, true, true>(ldsl, g, S, E, C.wave_s); }
            { Gemm g{(const bf16_t*)(C.ws + WS_YC), WB + (size_t)2 * DM * BW, Mx, DM, BW, BW}; EpiMerge<2> E{Z, accb}; gemm_phase<EpiMerge<2>, StaticOrder, true, true>(ldsl, g, S, E, C.wave_s); }
            SEAM(p0 + 7); }
        if (EN(9) && IN(p0 + 8)) { Gemm g{(const bf16_t*)(C.ws + WS_RKV), (const bf16_t*)(C.ws + WSP(l) + WS_WOT), Mx, DM, DM, DM}; StaticOrder S; S.init(Mx, DM, G, bid, 2);
            EpiRes E{l == 0 ? C.inp(I_X) : C.out, C.out, l == 0 ? C.inp(I_CTX) : (const float*)(C.ws + WS_XC), (float*)(C.ws + WS_XC), mods_l + 2 * DM,
                     1.0f};
            gemm_phase<EpiRes, StaticOrder, true, true>(ldsl, g, S, E, C.wave_s); SEAM(p0 + 8); }
        if (EN(10) && IN(p0 + 9)) { ph_norm(C, l, 1, Mx); SEAM(p0 + 9); }
        if (EN(11) && IN(p0 + 10)) { Gemm g{H, (const bf16_t*)(C.ws + WSP(l) + WS_WFIT), Mx, NFI, DM, DM}; StaticOrder S; S.init(Mx, NFI, G, bid, 4); EpiSwiglu E{Z};
            gemm_phase<EpiSwiglu, StaticOrder, true, true>(ldsl, g, S, E, C.wave_s); SEAM(p0 + 10); }
        if (EN(12) && IN(p0 + 11)) { Gemm g{Z, (const bf16_t*)(C.ws + WSP(l) + WS_WFOT), Mx, DM, DFF, DFF}; StaticOrder S; S.init(Mx, DM, G, bid, 2);
            EpiRes E{C.out, C.out, (const float*)(C.ws + WS_XC), (float*)(C.ws + WS_XC), mods_l + 5 * DM, 1.0f};
            gemm_phase<EpiRes, StaticOrder, true, true>(ldsl, g, S, E, C.wave_s);
            if (l + 1 < DEPTH) {
                const int _G = G, _b = bid, _nwg = (Mx / 256) * (DM / 256), _nl = _nwg - (_nwg / _G) * _G;
                if (_b >= _nl) { const Ctx C2 = ctx_sub(C, _b - _nl, _G - _nl); ph_wprep(C2, l + 1); } }
            SEAM(p0 + 11); }
    }
#undef G
#undef bid
    if (EN(13) && IN(N_PHASES - 1)) ph_final(C);
#undef IN
#undef SEAM
}


#ifndef PH_MASK
#define PH_MASK 0xFFFFu
#endif
template <unsigned KMASK> __global__ void __launch_bounds__(NTHR, 2) mk_k(Args args) {
    mk_body<KMASK>(args);
}
#if !MK_SPLIT
__global__ void __launch_bounds__(NTHR, 2) mk_fwd(Args args) { mk_body<PH_MASK>(args); }
#endif
static inline int kind_of(int p) { return p == 0 ? 0 : p == N_PHASES - 1 ? 13 : 1 + (p - 1) % PH_PER_LAYER; }
typedef void (*kern_t)(Args);
static kern_t kern_of(int kind) {
    switch (kind) { case 0: return mk_k<1u << 0>; case 1: return mk_k<1u << 1>; case 2: return mk_k<1u << 2>; case 3: return mk_k<1u << 3>; case 4: return mk_k<1u << 4>; case 5: return mk_k<1u << 5>; case 6: return mk_k<1u << 6>;
                    case 7: return mk_k<1u << 7>; case 8: return mk_k<1u << 8>; case 9: return mk_k<1u << 9>; case 10: return mk_k<1u << 10>; case 11: return mk_k<1u << 11>; case 12: return mk_k<1u << 12>; default: return mk_k<1u << 13>; }
}
extern "C" void kernel_launch(void* const* d_in, const int* in_sizes, int n_in, void* d_out, int out_size, void* d_ws, size_t ws_size, hipStream_t stream) {
    static int grid = 0;
    if (grid == 0) {
        if (n_in != N_IN || out_size != ML * DM || ws_size < WS_END) { fprintf(stderr, "kernel_launch: shape mismatch: n_in %d out %d ws %zu (need %zu)\n", n_in, out_size, ws_size, (size_t)WS_END); grid = -1; return; }
        int dev = 0, cus = 0, per_cu = 0;
        if (hipGetDevice(&dev) != hipSuccess || hipDeviceGetAttribute(&cus, hipDeviceAttributeMultiprocessorCount, dev) != hipSuccess) { grid = -1; return; }
#if MK_SPLIT
        for (int k = 0; k < 14; ++k) if (hipFuncSetAttribute((const void*)kern_of(k), hipFuncAttributeMaxDynamicSharedMemorySize, LDS_BYTES) != hipSuccess) { fprintf(stderr, "kernel_launch: hipFuncSetAttribute failed (kind %d)\n", k); grid = -1; return; }
        (void)per_cu;
#else
        if (hipFuncSetAttribute((const void*)mk_fwd, hipFuncAttributeMaxDynamicSharedMemorySize, LDS_BYTES) != hipSuccess) { fprintf(stderr, "kernel_launch: hipFuncSetAttribute failed\n"); grid = -1; return; }
        if (hipOccupancyMaxActiveBlocksPerMultiprocessor(&per_cu, (const void*)mk_fwd, NTHR, LDS_BYTES) != hipSuccess || per_cu < 1) fprintf(stderr, "kernel_launch: occupancy query says %d\n", per_cu);
#endif
        (void)hipGetLastError();
        grid = cus;
    }
    if (grid < 0) return;
    if (hipMemsetAsync((char*)d_ws + WS_CTL, 0, CTL_ZERO_BYTES, stream) != hipSuccess) { fprintf(stderr, "kernel_launch: memset failed\n"); return; }
    Args a{};
    for (int i = 0; i < N_IN; ++i) a.in[i] = (const float*)d_in[i];
    a.out = (float*)d_out; a.ws = (unsigned char*)d_ws; a.bar_region = 0; a.pad = 0;
#if MK_SPLIT
    for (int p = 0; p < N_PHASES; ++p) {
        a.ph_lo = p; a.ph_hi = p + 1;
        const int kind = kind_of(p);
        hipLaunchKernelGGL(kern_of(kind), dim3(grid), dim3(NTHR), LDS_BYTES, stream, a);
    }
#else
    a.ph_lo = 0; a.ph_hi = N_PHASES; hipLaunchKernelGGL(mk_fwd, dim3(grid), dim3(NTHR), LDS_BYTES, stream, a);
#endif
    const hipError_t le = hipPeekAtLastError();
    if (le != hipSuccess) fprintf(stderr, "kernel_launch: launch failed: %s\n", hipGetErrorName(le));
}
```

```cpp
#include <hip/hip_runtime.h>
#include <cstdio>
#include <cstdint>

__device__ __forceinline__ int lane_id_asm() { int l; asm volatile("v_mbcnt_lo_u32_b32 %0, -1, 0\n\tv_mbcnt_hi_u32_b32 %0, -1, %0" : "=v"(l)); return l; }

namespace pg8 {
#define PG8_LAS __attribute__((address_space(3)))
typedef unsigned short bf16_t;
typedef short bf16x8 __attribute__((ext_vector_type(8)));
typedef float f32x4 __attribute__((ext_vector_type(4)));
typedef unsigned u32x4 __attribute__((ext_vector_type(4)));
constexpr int BM = 256, BK = 64, HALF = 128, HTB = HALF * BK * 2  , STAGE_BYTES = 8 * HTB, NXCD = 8, WGM = 4;

__host__ __device__ __forceinline__ int lds_byte(int r, int c) { const int st = (r >> 4) * 2 + (c >> 5), rr = r & 15, cc = c & 31, ob = rr * 64 + cc * 2; return st * 1024 + (ob ^ (((ob >> 9) & 1) << 5)); }
__host__ __device__ __forceinline__ void stage_rc(int b, int& R, int& C) { const int st = b / 1024, sb = b % 1024, swz = sb ^ (((sb >> 9) & 1) << 5); R = (st >> 1) * 16 + swz / 64; C = (st & 1) * 32 + (swz % 64) / 2; }
__host__ __device__ __forceinline__ int perm32(int rho) { const int n = rho >> 4, i = rho & 15; return 8 * (i >> 2) + 4 * n + (i & 3); }

struct Unit { int pm, pn; };
struct Gemm { const bf16_t* A; const bf16_t* Bt; int M, N, K, lda; };

struct StaticOrder {
    int nM, nN, nwg, G, c, wgm;
    __host__ __device__ void init(int M, int N, int G_, int c_, int wgm_ = WGM) { nM = M / BM; nN = N / BM; nwg = nM * nN; G = G_; c = c_; wgm = wgm_; }
    __host__ __device__ bool next(int i, Unit& u) const {
        const long L = (long)i * G + c; if (L >= nwg) return false;
        int wgid = (int)L; { const int q = nwg / NXCD, r = nwg % NXCD, xcd = wgid % NXCD, off = wgid / NXCD; wgid = (xcd < r ? xcd * (q + 1) : r * (q + 1) + (xcd - r) * q) + off; }
        const int nig = wgm * nN, gid = wgid / nig, fm = gid * wgm, gsz = (nM - fm) < wgm ? (nM - fm) : wgm;
        u.pm = fm + ((wgid % nig) % gsz); u.pn = (wgid % nig) / gsz; return true;
    }
    __device__ __forceinline__ void a_ready(const Unit&) const {}
    __device__ __forceinline__ void done(const Unit&) const {}
};
typedef __bf16 bf16x2_t __attribute__((ext_vector_type(2)));
typedef float f32x2_t __attribute__((ext_vector_type(2)));
__device__ __forceinline__ unsigned cvt_pk_bf16(float lo, float hi) { const f32x2_t v = {lo, hi}; const bf16x2_t b = __builtin_convertvector(v, bf16x2_t); return __builtin_bit_cast(unsigned, b); }
typedef float f32x2 __attribute__((ext_vector_type(2)));

template <class Epi, class Sched, bool ALIGN_EPI = false, bool SP2 = false>
__device__ __forceinline__ void gemm_phase(PG8_LAS unsigned char* lds, const Gemm g, const Sched& S, const Epi& E, int wave_s) {
    int tid_ = (wave_s << 6) | lane_id_asm(); asm volatile("" : "+v"(tid_)); const int tid = tid_, wid = __builtin_amdgcn_readfirstlane(tid >> 6), lane = tid & 63, wr = wid >> 2, wc = wid & 3, fr = lane & 15, fq = lane >> 4;
    const int K = g.K, nt = K / BK;
    unsigned voffA[2], voffB[2];
#pragma unroll
    for (int i = 0; i < 2; ++i) { int R, C; stage_rc(tid * 16 + i * 8192, R, C); const int Rb = Epi::PERM ? ((R & ~31) + perm32(R & 31)) : R;
        voffA[i] = (unsigned)(R * g.lda + C) * 2u; voffB[i] = (unsigned)(Rb * K + C) * 2u; }
    const size_t kstep = (size_t)(BK * 2);
    const size_t hstepB = (size_t)HALF * K * 2, hstepA = (size_t)HALF * g.lda * 2;
    const size_t tstepA = 2 * hstepA, tstepB = 2 * hstepB;
    const unsigned ldsw = (unsigned)wid * 1024u;
    const int aoff = lds_byte(wr * 64 + fr, fq * 8), boff = lds_byte(wc * 32 + fr, fq * 8);
#define PG8_SA(b, h) (((b) * 2 + (h)) * HTB)
#define PG8_SB(b, h) ((4 + (b) * 2 + (h)) * HTB)
#define PG8_STAGE(bufoff, gbase, voff) do { _Pragma("unroll") for (int _i = 0; _i < 2; ++_i) \
        __builtin_amdgcn_global_load_lds((const unsigned*)((const char*)(gbase) + (voff)[_i]), (PG8_LAS unsigned*)(lds + (bufoff) + ldsw + _i * 8192), 16, 0, 0); } while (0)
#define PG8_LDA(dst, b, h) do { _Pragma("unroll") for (int m = 0; m < 4; ++m) _Pragma("unroll") for (int k = 0; k < 2; ++k) dst[m][k] = *(const PG8_LAS bf16x8*)(lds + PG8_SA(b, h) + aoff + m * 2048 + k * 1024); } while (0)
#define PG8_LDB(dst, b, h) do { _Pragma("unroll") for (int n = 0; n < 2; ++n) _Pragma("unroll") for (int k = 0; k < 2; ++k) dst[n][k] = *(const PG8_LAS bf16x8*)(lds + PG8_SB(b, h) + boff + n * 2048 + k * 1024); } while (0)
#define PG8_MMA(ai, bj, At, Bt) do { __builtin_amdgcn_s_setprio(1); _Pragma("unroll") for (int m = 0; m < 4; ++m) _Pragma("unroll") for (int n = 0; n < 2; ++n) _Pragma("unroll") for (int k = 0; k < 2; ++k) \
        acc[ai][bj][m][n] = __builtin_amdgcn_mfma_f32_16x16x32_bf16(Bt[n][k], At[m][k], acc[ai][bj][m][n], 0, 0, 0); __builtin_amdgcn_s_setprio(0); } while (0)
#define PG8_WAIT_V(n) asm volatile("s_waitcnt vmcnt(" #n ")" ::: "memory")
#define PG8_WAIT_L(n) asm volatile("s_waitcnt lgkmcnt(" #n ")" ::: "memory")
#define PG8_BAR __builtin_amdgcn_s_barrier()
#define PG8_SCHED __builtin_amdgcn_sched_barrier(0)
    Unit cur, nxt; int ui = 0;
    if (!S.next(0, cur)) return;
    f32x4 acc[2][2][4][2];
#pragma unroll
    for (int a = 0; a < 2; ++a)
#pragma unroll
        for (int b = 0; b < 2; ++b)
#pragma unroll
            for (int m = 0; m < 4; ++m)
#pragma unroll
                for (int n = 0; n < 2; ++n) acc[a][b][m][n] = (f32x4){0.f, 0.f, 0.f, 0.f};
    bf16x8 At[4][2], B0[2][2], B1[2][2];
    const char* cA = (const char*)g.A + (size_t)cur.pm * tstepA; const char* cB = (const char*)g.Bt + (size_t)cur.pn * tstepB;
    S.a_ready(cur);
    if constexpr (SP2) {
        PG8_STAGE(PG8_SB(0, 0), cB, voffB); PG8_STAGE(PG8_SB(0, 1), cB + hstepB, voffB); PG8_STAGE(PG8_SA(0, 0), cA, voffA); PG8_STAGE(PG8_SA(0, 1), cA + hstepA, voffA);
        if (wr == 1) PG8_BAR;
        PG8_WAIT_V(2); PG8_BAR;
        PG8_STAGE(PG8_SB(1, 0), cB + kstep, voffB); PG8_STAGE(PG8_SA(1, 0), cA + kstep, voffA); PG8_STAGE(PG8_SB(1, 1), cB + hstepB + kstep, voffB);
        PG8_WAIT_V(6); PG8_BAR;
    } else {
        PG8_STAGE(PG8_SB(0, 0), cB, voffB); PG8_STAGE(PG8_SA(0, 0), cA, voffA); PG8_STAGE(PG8_SB(0, 1), cB + hstepB, voffB); PG8_STAGE(PG8_SA(0, 1), cA + hstepA, voffA);
        if (wr == 1) PG8_BAR;
        PG8_WAIT_V(4); PG8_BAR;
        PG8_STAGE(PG8_SB(1, 0), cB + kstep, voffB); PG8_STAGE(PG8_SA(1, 0), cA + kstep, voffA); PG8_STAGE(PG8_SB(1, 1), cB + hstepB + kstep, voffB);
        PG8_WAIT_V(6); PG8_BAR;
    }
    for (;;) {
        const bool has_next = S.next(ui + 1, nxt);
        const char* nA = has_next ? (const char*)g.A + (size_t)nxt.pm * tstepA : cA; const char* nB = has_next ? (const char*)g.Bt + (size_t)nxt.pn * tstepB : cB;
        for (int t = 0; t < nt; t += 2) {
            const bool last = (t == nt - 2);
            const char* a1 = cA + (size_t)(t + 1) * kstep;
            const char* a2 = last ? nA : cA + (size_t)(t + 2) * kstep; const char* b2 = last ? nB : cB + (size_t)(t + 2) * kstep;
            const char* a3 = a2 + kstep; const char* b3 = b2 + kstep;
            if (last && has_next) S.a_ready(nxt);
            if constexpr (SP2) {
            PG8_LDB(B0, 0, 0); PG8_LDB(B1, 0, 1); PG8_SCHED; PG8_LDA(At, 0, 0); PG8_STAGE(PG8_SA(1, 1), a1 + hstepA, voffA);
            PG8_WAIT_V(8); PG8_WAIT_L(0); PG8_BAR; PG8_MMA(0, 0, At, B0); PG8_MMA(0, 1, At, B1); PG8_BAR; PG8_SCHED;
            PG8_LDA(At, 0, 1); PG8_STAGE(PG8_SB(0, 0), b2, voffB); PG8_STAGE(PG8_SB(0, 1), b2 + hstepB, voffB); PG8_STAGE(PG8_SA(0, 0), a2, voffA);
            PG8_WAIT_V(8); PG8_WAIT_L(0); PG8_BAR; PG8_MMA(1, 0, At, B0); PG8_MMA(1, 1, At, B1); PG8_BAR; PG8_SCHED;
            PG8_LDB(B0, 1, 0); PG8_LDB(B1, 1, 1); PG8_SCHED; PG8_LDA(At, 1, 0); PG8_STAGE(PG8_SA(0, 1), a2 + hstepA, voffA);
            PG8_WAIT_V(8); PG8_WAIT_L(0); PG8_BAR; PG8_MMA(0, 0, At, B0); PG8_MMA(0, 1, At, B1); PG8_BAR; PG8_SCHED;
            PG8_LDA(At, 1, 1); PG8_STAGE(PG8_SB(1, 0), b3, voffB); PG8_STAGE(PG8_SB(1, 1), b3 + hstepB, voffB); PG8_STAGE(PG8_SA(1, 0), a3, voffA);
            PG8_WAIT_V(8); PG8_WAIT_L(0); PG8_BAR; PG8_MMA(1, 0, At, B0); PG8_MMA(1, 1, At, B1); PG8_BAR; PG8_SCHED;
            } else {
            PG8_LDB(B0, 0, 0); PG8_SCHED; PG8_LDA(At, 0, 0); PG8_STAGE(PG8_SA(1, 1), a1 + hstepA, voffA);
            PG8_WAIT_L(8); PG8_BAR; PG8_WAIT_L(0); PG8_MMA(0, 0, At, B0); PG8_BAR; PG8_SCHED;
            PG8_LDB(B1, 0, 1); PG8_STAGE(PG8_SB(0, 0), b2, voffB);
            PG8_BAR; PG8_WAIT_L(0); PG8_MMA(0, 1, At, B1); PG8_BAR;
            PG8_LDA(At, 0, 1); PG8_STAGE(PG8_SA(0, 0), a2, voffA);
            PG8_BAR; PG8_WAIT_L(0); PG8_MMA(1, 0, At, B0); PG8_BAR; PG8_SCHED;
            PG8_STAGE(PG8_SB(0, 1), b2 + hstepB, voffB);
            PG8_WAIT_V(6); PG8_BAR; PG8_MMA(1, 1, At, B1); PG8_BAR;
            PG8_LDB(B0, 1, 0); PG8_SCHED; PG8_LDA(At, 1, 0); PG8_STAGE(PG8_SA(0, 1), a2 + hstepA, voffA);
            PG8_WAIT_L(8); PG8_BAR; PG8_WAIT_L(0); PG8_MMA(0, 0, At, B0); PG8_BAR; PG8_SCHED;
            PG8_LDB(B1, 1, 1); PG8_STAGE(PG8_SB(1, 0), b3, voffB);
            PG8_BAR; PG8_WAIT_L(0); PG8_MMA(0, 1, At, B1); PG8_BAR;
            PG8_LDA(At, 1, 1); PG8_STAGE(PG8_SA(1, 0), a3, voffA);
            PG8_BAR; PG8_WAIT_L(0); PG8_MMA(1, 0, At, B0); PG8_BAR; PG8_SCHED;
            PG8_STAGE(PG8_SB(1, 1), b3 + hstepB, voffB);
            PG8_WAIT_V(6); PG8_BAR; PG8_MMA(1, 1, At, B1); PG8_BAR;
            }
        }
        if constexpr (ALIGN_EPI) { if (wr == 0) PG8_BAR; }
        if constexpr (!Epi::AFTER_DRAIN) {
            const int l2 = lane_id_asm(); E(acc, cur, wr, wc, l2 & 15, l2 >> 4); S.done(cur); }
        if (!has_next) break;
#pragma unroll
        for (int a = 0; a < 2; ++a)
#pragma unroll
            for (int b = 0; b < 2; ++b)
#pragma unroll
                for (int m = 0; m < 4; ++m)
#pragma unroll
                    for (int n = 0; n < 2; ++n) acc[a][b][m][n] = (f32x4){0.f, 0.f, 0.f, 0.f};
        cur = nxt; cA = nA; cB = nB; ++ui;
        if constexpr (ALIGN_EPI) { if (wr == 1) PG8_BAR; }
    }
    PG8_WAIT_V(0);
    if constexpr (!ALIGN_EPI) { if (wr == 0) PG8_BAR; }
    PG8_BAR;
    if constexpr (Epi::AFTER_DRAIN) { E.fused(acc, cur, wr, wc, fr, fq, lds, wid, lane); S.done(cur); }
#undef PG8_SA
#undef PG8_SB
#undef PG8_STAGE
#undef PG8_LDA
#undef PG8_LDB
#undef PG8_MMA
#undef PG8_WAIT_V
#undef PG8_WAIT_L
#undef PG8_BAR
#undef PG8_SCHED
}
}

namespace pg8 {
typedef unsigned u32x2 __attribute__((ext_vector_type(2)));
typedef _Float16 f16x8 __attribute__((ext_vector_type(8)));
__device__ __forceinline__ float sigmoidf_(float x) { return __builtin_amdgcn_rcpf(1.0f + __expf(-x)); }
__device__ __forceinline__ float bf_lo(unsigned w) { return __uint_as_float(w << 16); }
__device__ __forceinline__ float bf_hi(unsigned w) { return __uint_as_float(w & 0xffff0000u); }

struct EpiZ1 {
    static constexpr bool PERM = true, AFTER_DRAIN = false;
    bf16_t* O;
    __device__ __forceinline__ void operator()(const f32x4 (&acc)[2][2][4][2], const Unit& u, int wr, int wc, int fr, int fq) const {
        const int row0 = u.pm * BM + wr * 64 + fr, col0 = u.pn * BM + wc * 32 + 8 * fq;
#pragma unroll
        for (int ai = 0; ai < 2; ++ai)
#pragma unroll
            for (int m = 0; m < 4; ++m) { bf16_t* rowp = O + (size_t)(row0 + ai * HALF + m * 16) * 4608 + col0;
#pragma unroll
                for (int bj = 0; bj < 2; ++bj) { f32x4 v0 = acc[ai][bj][m][0], v1 = acc[ai][bj][m][1];
                    if (bj == 0 && u.pn == 12) {
#pragma unroll
                        for (int j = 0; j < 4; ++j) { v0[j] = tanhf(v0[j]); v1[j] = tanhf(v1[j]); } }
                    if (bj == 0 && u.pn == 13) {
#pragma unroll
                        for (int j = 0; j < 4; ++j) { v0[j] = sigmoidf_(v0[j]); v1[j] = sigmoidf_(v1[j]); } }
                    u32x4 w; w.x = cvt_pk_bf16(v0[0], v0[1]); w.y = cvt_pk_bf16(v0[2], v0[3]); w.z = cvt_pk_bf16(v1[0], v1[1]); w.w = cvt_pk_bf16(v1[2], v1[3]);
                    *(u32x4*)(rowp + bj * HALF) = w; } }
    }
};
struct EpiZ2 {
    static constexpr bool PERM = true, AFTER_DRAIN = false;
    bf16_t* O; const float* cosT; const float* sinT;
    __device__ __forceinline__ void operator()(const f32x4 (&acc)[2][2][4][2], const Unit& u, int wr, int wc, int fr, int fq) const {
        const int row0 = u.pm * BM + wr * 64 + fr;
        if (u.pn >= 8) {
            const int col0 = u.pn * BM + wc * 32 + 8 * fq;
#pragma unroll
            for (int ai = 0; ai < 2; ++ai)
#pragma unroll
                for (int m = 0; m < 4; ++m) { bf16_t* rowp = O + (size_t)(row0 + ai * HALF + m * 16) * 3072 + col0;
#pragma unroll
                    for (int bj = 0; bj < 2; ++bj) { const f32x4 v0 = acc[ai][bj][m][0], v1 = acc[ai][bj][m][1];
                        u32x4 w; w.x = cvt_pk_bf16(v0[0], v0[1]); w.y = cvt_pk_bf16(v0[2], v0[3]); w.z = cvt_pk_bf16(v1[0], v1[1]); w.w = cvt_pk_bf16(v1[2], v1[3]);
                        *(u32x4*)(rowp + bj * HALF) = w; } }
            return;
        }
        const bool rope = u.pm < 128; const int axis = wc & 1;
        const int colg = u.pn * BM + wc * 32 + 4 * fq;
#pragma unroll
        for (int ai = 0; ai < 2; ++ai)
#pragma unroll
            for (int m = 0; m < 4; ++m) { const int row = row0 + ai * HALF + m * 16; bf16_t* rowp = O + (size_t)row * 3072 + colg;
                f32x4 cs = (f32x4){1.f, 1.f, 1.f, 1.f}, sn = (f32x4){0.f, 0.f, 0.f, 0.f};
                if (rope) { const int t = row & 4095, pos = axis ? (t & 63) : (t >> 6); cs = *(const f32x4*)(cosT + pos * 16 + 4 * fq); sn = *(const f32x4*)(sinT + pos * 16 + 4 * fq); }
#pragma unroll
                for (int bj = 0; bj < 2; ++bj) { const f32x4 a = acc[ai][bj][m][0], b = acc[ai][bj][m][1];
                    const f32x4 ra = a * cs - b * sn, rb = a * sn + b * cs;
                    u32x2 wa, wb; wa.x = cvt_pk_bf16(ra[0], ra[1]); wa.y = cvt_pk_bf16(ra[2], ra[3]); wb.x = cvt_pk_bf16(rb[0], rb[1]); wb.y = cvt_pk_bf16(rb[2], rb[3]);
                    *(u32x2*)(rowp + bj * HALF) = wa; *(u32x2*)(rowp + bj * HALF + 16) = wb; } }
    }
};
struct EpiGate {
    static constexpr bool PERM = true, AFTER_DRAIN = false;
    bf16_t* O;
    __device__ __forceinline__ void operator()(const f32x4 (&acc)[2][2][4][2], const Unit& u, int wr, int wc, int fr, int fq) const {
        const int row0 = u.pm * BM + wr * 64 + fr, col0 = u.pn * BM + wc * 32 + 8 * fq;
#pragma unroll
        for (int ai = 0; ai < 2; ++ai)
#pragma unroll
            for (int m = 0; m < 4; ++m) { bf16_t* rowp = O + (size_t)(row0 + ai * HALF + m * 16) * 6144 + col0;
#pragma unroll
                for (int bj = 0; bj < 2; ++bj) { f32x4 v0 = acc[ai][bj][m][0], v1 = acc[ai][bj][m][1];
#pragma unroll
                    for (int j = 0; j < 4; ++j) { v0[j] = sigmoidf_(v0[j]); v1[j] = sigmoidf_(v1[j]); }
                    u32x4 w; w.x = cvt_pk_bf16(v0[0], v0[1]); w.y = cvt_pk_bf16(v0[2], v0[3]); w.z = cvt_pk_bf16(v1[0], v1[1]); w.w = cvt_pk_bf16(v1[2], v1[3]);
                    *(u32x4*)(rowp + bj * HALF) = w; } }
    }
};
struct EpiLr {
    static constexpr bool PERM = true, AFTER_DRAIN = false;
    _Float16* O;
    __device__ __forceinline__ void operator()(const f32x4 (&acc)[2][2][4][2], const Unit& u, int wr, int wc, int fr, int fq) const {
        const int row0 = u.pm * BM + wr * 64 + fr, col0 = u.pn * BM + wc * 32 + 8 * fq;
#pragma unroll
        for (int bj = 0; bj < 2; ++bj)
#pragma unroll
            for (int ai = 0; ai < 2; ++ai)
#pragma unroll
                for (int m = 0; m < 4; ++m) { _Float16* rowp = O + (size_t)(row0 + ai * HALF + m * 16) * 5120 + col0 + bj * HALF;
                    const f32x4 v0 = acc[ai][bj][m][0], v1 = acc[ai][bj][m][1];
                    f16x8 w; w[0] = (_Float16)v0[0]; w[1] = (_Float16)v0[1]; w[2] = (_Float16)v0[2]; w[3] = (_Float16)v0[3]; w[4] = (_Float16)v1[0]; w[5] = (_Float16)v1[1]; w[6] = (_Float16)v1[2]; w[7] = (_Float16)v1[3];
                    *(f16x8*)rowp = w; asm volatile("" ::: "memory"); }
    }
};
template <int PASS> struct EpiMerge {
    static constexpr bool PERM = false, AFTER_DRAIN = false;
    const bf16_t* gates; bf16_t* accb;
    __device__ __forceinline__ void operator()(const f32x4 (&acc)[2][2][4][2], const Unit& u, int wr, int wc, int fr, int fq) const {
        const int row0 = u.pm * BM + wr * 64 + fr, col0 = u.pn * BM + wc * 32 + 4 * fq;
#pragma unroll
        for (int ai = 0; ai < 2; ++ai)
#pragma unroll
            for (int m = 0; m < 4; ++m) { const size_t row = (size_t)(row0 + ai * HALF + m * 16);
#pragma unroll
                for (int bj = 0; bj < 2; ++bj)
#pragma unroll
                    for (int n = 0; n < 2; ++n) { const int c = col0 + bj * HALF + n * 16;
                        const u32x2 gw = *(const u32x2*)(gates + row * 6144 + PASS * 2048 + c);
                        f32x4 v = acc[ai][bj][m][n]; v[0] *= bf_lo(gw.x); v[1] *= bf_hi(gw.x); v[2] *= bf_lo(gw.y); v[3] *= bf_hi(gw.y);
                        if (PASS != 0) { const u32x2 pw = *(const u32x2*)(accb + row * 2048 + c); v[0] += bf_lo(pw.x); v[1] += bf_hi(pw.x); v[2] += bf_lo(pw.y); v[3] += bf_hi(pw.y); }
                        u32x2 w; w.x = cvt_pk_bf16(v[0], v[1]); w.y = cvt_pk_bf16(v[2], v[3]); *(u32x2*)(accb + row * 2048 + c) = w; } }
    }
};
struct EpiRes {
    static constexpr bool PERM = false, AFTER_DRAIN = false;
    const float* xin_l; float* xout_l; const float* xin_c; float* xout_c; const float* mod; float gain;
    __device__ __forceinline__ void operator()(const f32x4 (&acc)[2][2][4][2], const Unit& u, int wr, int wc, int fr, int fq) const {
        const bool lat = u.pm < 128; const int prow = lat ? u.pm * BM : (u.pm - 128) * BM;
        const float* xi = lat ? xin_l : xin_c; float* xo = lat ? xout_l : xout_c; const float* mv = mod + (size_t)(lat ? (u.pm >> 4) : 8) * 12288;
        const int row0 = prow + wr * 64 + fr, col0 = u.pn * BM + wc * 32 + 4 * fq;
        f32x4 mvv[2][2];
#pragma unroll
        for (int bj = 0; bj < 2; ++bj)
#pragma unroll
            for (int n = 0; n < 2; ++n) mvv[bj][n] = *(const f32x4*)(mv + col0 + bj * HALF + n * 16);
#pragma unroll
        for (int ai = 0; ai < 2; ++ai)
#pragma unroll
            for (int m = 0; m < 4; ++m) { const size_t off = (size_t)(row0 + ai * HALF + m * 16) * 2048 + col0;
#pragma unroll
                for (int bj = 0; bj < 2; ++bj)
#pragma unroll
                    for (int n = 0; n < 2; ++n) { const f32x4 b = *(const f32x4*)(xi + off + bj * HALF + n * 16); *(f32x4*)(xo + off + bj * HALF + n * 16) = b + (mvv[bj][n] * gain) * acc[ai][bj][m][n]; } }
    }
};
struct EpiSwiglu {
    static constexpr bool PERM = true, AFTER_DRAIN = false;
    bf16_t* O;
    __device__ __forceinline__ void operator()(const f32x4 (&acc)[2][2][4][2], const Unit& u, int wr, int wc, int fr, int fq) const {
        const int row0 = u.pm * BM + wr * 64 + fr, col0 = u.pn * HALF + wc * 32 + 8 * fq;
#pragma unroll
        for (int ai = 0; ai < 2; ++ai)
#pragma unroll
            for (int m = 0; m < 4; ++m) { bf16_t* rowp = O + (size_t)(row0 + ai * HALF + m * 16) * 5632 + col0;
                f32x4 v0 = acc[ai][0][m][0], v1 = acc[ai][0][m][1]; const f32x4 u0 = acc[ai][1][m][0], u1 = acc[ai][1][m][1];
#pragma unroll
                for (int j = 0; j < 4; ++j) { v0[j] = v0[j] * sigmoidf_(v0[j]) * u0[j]; v1[j] = v1[j] * sigmoidf_(v1[j]) * u1[j]; }
                u32x4 w; w.x = cvt_pk_bf16(v0[0], v0[1]); w.y = cvt_pk_bf16(v0[2], v0[3]); w.z = cvt_pk_bf16(v1[0], v1[1]); w.w = cvt_pk_bf16(v1[2], v1[3]);
                *(u32x4*)rowp = w; }
    }
};
}

namespace att {
using bf16 = unsigned short;
using bf16x8 = __attribute__((ext_vector_type(8))) short;
using s16x4  = __attribute__((ext_vector_type(4))) short;
using f32x16 = __attribute__((ext_vector_type(16))) float;
using u32x4  = __attribute__((ext_vector_type(4))) unsigned;
constexpr int NW = 8, QBLK = 32, KVBLK = 64, LDZ = 3072;
constexpr float SCALE = 0.125f, THR = 8.f;
constexpr int SHM_V = KVBLK * 128 * 2, SHM_K = KVBLK * 64 * 2, SHM_ATTN = 2 * SHM_V + 2 * SHM_K + NW * 64 * 4;
#define ATT_KSWZ(row, colB) ((row) * 128 + ((colB) ^ ((((row) >> 1) & 7) << 4)))
#define ATT_SBAR() __builtin_amdgcn_sched_barrier(0)
__device__ __forceinline__ int crow(int r, int hi) { return (r & 3) + 8 * (r >> 2) + 4 * hi; }
typedef __bf16 bf16x2_t __attribute__((ext_vector_type(2)));
typedef float f32x2_t __attribute__((ext_vector_type(2)));
__device__ __forceinline__ unsigned cvtpk(float lo, float hi) { const f32x2_t v = {lo, hi}; const bf16x2_t b = __builtin_convertvector(v, bf16x2_t); return __builtin_bit_cast(unsigned, b); }
__device__ __forceinline__ bf16x8 ld8(const bf16* p) { return *reinterpret_cast<const bf16x8*>(p); }

__device__ __forceinline__ void partialSM(f32x16& p0, f32x16& p1, float& m_reg, float& mn, float& alpha) {
  constexpr float C = SCALE * 1.4426950408889634f;
  float pmax = p0[0];
#pragma unroll
  for (int r = 1; r < 16; ++r) pmax = fmaxf(pmax, p0[r]);
#pragma unroll
  for (int r = 0; r < 16; ++r) pmax = fmaxf(pmax, p1[r]);
  { auto rr = __builtin_amdgcn_permlane32_swap(__float_as_uint(pmax), __float_as_uint(pmax), false, false);
    pmax = fmaxf(__uint_as_float(rr[0]), __uint_as_float(rr[1])); }
  if (__builtin_expect(__all(pmax - m_reg <= THR / SCALE), 1)) { mn = m_reg; alpha = 1.f; }
  else { mn = fmaxf(m_reg, pmax); alpha = __builtin_amdgcn_exp2f((m_reg - mn) * C); m_reg = mn; }
  const float mnC = -mn * C;
#pragma unroll
  for (int r = 0; r < 16; ++r) p0[r] = fmaf(p0[r], C, mnC);
#pragma unroll
  for (int r = 0; r < 16; ++r) p1[r] = fmaf(p1[r], C, mnC);
#pragma unroll
  for (int r = 0; r < 16; ++r) p0[r] = __builtin_amdgcn_exp2f(p0[r]);
}
__device__ __forceinline__ void finishSM(f32x16& p0, f32x16& p1, float alpha, float& l_reg, bf16x8& pa0, bf16x8& pa1, bf16x8& pa2, bf16x8& pa3) {
#pragma unroll
  for (int r = 0; r < 16; ++r) p1[r] = __builtin_amdgcn_exp2f(p1[r]);
  float ps = 0;
#pragma unroll
  for (int r = 0; r < 16; ++r) ps += p0[r];
#pragma unroll
  for (int r = 0; r < 16; ++r) ps += p1[r];
  { auto rr = __builtin_amdgcn_permlane32_swap(__float_as_uint(ps), __float_as_uint(ps), false, false);
    ps = __uint_as_float(rr[0]) + __uint_as_float(rr[1]); }
  l_reg = l_reg * alpha + ps;
#define ATT_PK4(P, BASE, OUT) do { unsigned a0 = cvtpk(P[BASE + 0], P[BASE + 1]), a1 = cvtpk(P[BASE + 2], P[BASE + 3]);   \
    unsigned b0 = cvtpk(P[BASE + 4], P[BASE + 5]), b1 = cvtpk(P[BASE + 6], P[BASE + 7]);                              \
    auto r0 = __builtin_amdgcn_permlane32_swap(a0, b0, false, false); auto r1 = __builtin_amdgcn_permlane32_swap(a1, b1, false, false); \
    u32x4 w = {r0[0], r1[0], r0[1], r1[1]}; OUT = *reinterpret_cast<bf16x8*>(&w); } while (0)
  ATT_PK4(p0, 0, pa0); ATT_PK4(p0, 8, pa1); ATT_PK4(p1, 0, pa2); ATT_PK4(p1, 8, pa3);
#undef ATT_PK4
}
__device__ __forceinline__ void qkt(f32x16& p0, f32x16& p1, const char* Ks, const bf16x8* qr, int r32, int hi) {
  p0 = f32x16{}; p1 = f32x16{};
#pragma unroll
  for (int d0 = 0; d0 < 4; ++d0) { const int cb = (d0 * 16 + hi * 8) * 2;
    const bf16x8 b0 = *reinterpret_cast<const bf16x8*>(Ks + ATT_KSWZ(r32, cb));
    const bf16x8 b1 = *reinterpret_cast<const bf16x8*>(Ks + ATT_KSWZ(32 + r32, cb));
    p0 = __builtin_amdgcn_mfma_f32_32x32x16_bf16(b0, qr[d0], p0, 0, 0, 0);
    p1 = __builtin_amdgcn_mfma_f32_32x32x16_bf16(b1, qr[d0], p1, 0, 0, 0); }
}
__device__ __forceinline__ int v_st(int k, int c) { const int kk = (k & ~0xC) | ((k & 4) << 1) | ((k & 8) >> 1); return ((kk >> 3) * 4 + (c >> 5)) * 512 + ((kk & 7) * 32 + (c & 31)) * 2; }
__device__ __forceinline__ int v_rd_base(int lane) { return ((lane & 3) << 3) | (((lane >> 2) & 3) << 6) | (((lane >> 4) & 1) << 5) | (((lane >> 5) & 1) << 8); }
constexpr int v_rd_off(int d0, int ks, int half) { return d0 * 512 + ks * 4096 + half * 2048; }
template <int OFF> __device__ __forceinline__ s16x4 tr_read(int vb) {
  s16x4 r; asm volatile("ds_read_b64_tr_b16 %0, %1 offset:%2" : "=&v"(r) : "v"(vb), "i"(OFF) : "memory"); return r;
}
template <int D0> __device__ __forceinline__ void pv_one(f32x16& od, int vb, bf16x8 pa0, bf16x8 pa1, bf16x8 pa2, bf16x8 pa3) {
  const s16x4 l0 = tr_read<v_rd_off(D0, 0, 0)>(vb), h0 = tr_read<v_rd_off(D0, 0, 1)>(vb), l1 = tr_read<v_rd_off(D0, 1, 0)>(vb), h1 = tr_read<v_rd_off(D0, 1, 1)>(vb);
  const s16x4 l2 = tr_read<v_rd_off(D0, 2, 0)>(vb), h2 = tr_read<v_rd_off(D0, 2, 1)>(vb), l3 = tr_read<v_rd_off(D0, 3, 0)>(vb), h3 = tr_read<v_rd_off(D0, 3, 1)>(vb);
  asm volatile("s_waitcnt lgkmcnt(0)" ::: "memory"); ATT_SBAR();
#define ATT_PK(L, H) (bf16x8){L[0], L[1], L[2], L[3], H[0], H[1], H[2], H[3]}
  od = __builtin_amdgcn_mfma_f32_32x32x16_bf16(pa0, ATT_PK(l0, h0), od, 0, 0, 0);
  od = __builtin_amdgcn_mfma_f32_32x32x16_bf16(pa1, ATT_PK(l1, h1), od, 0, 0, 0);
  od = __builtin_amdgcn_mfma_f32_32x32x16_bf16(pa2, ATT_PK(l2, h2), od, 0, 0, 0);
  od = __builtin_amdgcn_mfma_f32_32x32x16_bf16(pa3, ATT_PK(l3, h3), od, 0, 0, 0);
#undef ATT_PK
}
__device__ __forceinline__ void pv_d0(f32x16* o, int vb, bf16x8 pa0, bf16x8 pa1, bf16x8 pa2, bf16x8 pa3) {
  pv_one<0>(o[0], vb, pa0, pa1, pa2, pa3); pv_one<1>(o[1], vb, pa0, pa1, pa2, pa3); pv_one<2>(o[2], vb, pa0, pa1, pa2, pa3); pv_one<3>(o[3], vb, pa0, pa1, pa2, pa3);
}

template <int STREAM>
__device__ __forceinline__ void body(const bf16* __restrict__ Z2, int qrow0, int klat0, int kctx0, int nlat, int NT, int qoff, int koff, int voff,
                                     float* __restrict__ tmp, bf16* __restrict__ Ob  , float lam, const float* __restrict__ subg, float oscale, char* lds, int wave_s) {
  int tid_ = (wave_s << 6) | lane_id_asm(); asm volatile("" : "+v"(tid_));
  const int tid = tid_, wid = tid >> 6, lane = tid & 63, r32 = lane & 31, hi = lane >> 5;
  char* V_lds = lds; char* K_lds = lds + 2 * SHM_V;
  float* ws = (float*)(lds + 2 * SHM_V + 2 * SHM_K) + wid * 64; float* li_l = ws; float* al_l = ws + 32;
  float m_reg = -1e30f, l_reg = 0; f32x16 o[4] = {}; bf16x8 qr[4];
  const bf16* Qw = Z2 + (size_t)(qrow0 + wid * QBLK + r32) * LDZ + qoff + hi * 8;
#pragma unroll
  for (int d0 = 0; d0 < 4; ++d0) qr[d0] = ld8(Qw + d0 * 16);
  const int sr = tid >> 4, sc = (tid & 15) * 8, vst0 = v_st(sr, sc), vst1 = v_st(32 + sr, sc);
  const int kr = tid >> 3, kst = ATT_KSWZ(kr, (tid & 7) * 16), kcol = koff + (tid & 7) * 8;
  const int vb0 = (int)(uintptr_t)V_lds + v_rd_base(lane);
  struct { bf16x8 vs0, vs1, ks0; } sr_[2];
#define ATT_KROW(j) ((j) < nlat ? klat0 + 64 * (j) : kctx0 + 64 * ((j) - nlat))
#define ATT_SLOAD(i, j) do { const int _r0 = ATT_KROW(j); sr_[i].vs0 = ld8(Z2 + (size_t)(_r0 + sr) * LDZ + voff + sc); sr_[i].vs1 = ld8(Z2 + (size_t)(_r0 + 32 + sr) * LDZ + voff + sc); \
    sr_[i].ks0 = ld8(Z2 + (size_t)(_r0 + kr) * LDZ + kcol); } while (0)
#define ATT_SWRITE(b, i) do { *(bf16x8*)(V_lds + (b) * SHM_V + vst0) = sr_[i].vs0; *(bf16x8*)(V_lds + (b) * SHM_V + vst1) = sr_[i].vs1; \
    *(bf16x8*)(K_lds + (b) * SHM_K + kst) = sr_[i].ks0; } while (0)
#define ATT_SWAIT() asm volatile("s_waitcnt vmcnt(3)" ::: "memory")
#define ATT_RESC(a) do { if (__any((a) < 1.f)) { if (hi == 0) al_l[r32] = (a); asm volatile("s_waitcnt lgkmcnt(0)" ::: "memory"); \
    _Pragma("unroll") for (int d = 0; d < 4; ++d) _Pragma("unroll") for (int r = 0; r < 16; ++r) o[d][r] *= al_l[crow(r, hi)]; } } while (0)
  f32x16 pA0, pA1, pB0, pB1; float mnA, mnB, alA, alB; bf16x8 pa0, pa1, pa2, pa3;
  constexpr int SE = 0, SO = 1;
  __syncthreads();
  ATT_SLOAD(SE, 0); asm volatile("s_waitcnt vmcnt(0)" ::: "memory"); ATT_SWRITE(0, SE); __syncthreads();
  qkt(pA0, pA1, K_lds, qr, r32, hi); partialSM(pA0, pA1, m_reg, mnA, alA);
  ATT_SLOAD(SO, 1); if (2 < NT) ATT_SLOAD(SE, 2);
  ATT_SWAIT(); ATT_SWRITE(1, SO); __syncthreads();
  for (int j = 1; j + 1 < NT; j += 2) {
    ATT_SBAR(); qkt(pB0, pB1, K_lds + SHM_K, qr, r32, hi);
    finishSM(pA0, pA1, alA, l_reg, pa0, pa1, pa2, pa3); ATT_SBAR();
    ATT_SLOAD(SO, j + 2); ATT_SBAR();
    pv_d0(o, vb0, pa0, pa1, pa2, pa3); partialSM(pB0, pB1, m_reg, mnB, alB);
    __syncthreads(); ATT_SWAIT(); ATT_SWRITE(0, SE);
    ATT_RESC(alB); __syncthreads();
    ATT_SBAR(); qkt(pA0, pA1, K_lds, qr, r32, hi);
    finishSM(pB0, pB1, alB, l_reg, pa0, pa1, pa2, pa3); ATT_SBAR();
    if (j + 3 < NT) ATT_SLOAD(SE, j + 3); ATT_SBAR();
    pv_d0(o, vb0 + SHM_V, pa0, pa1, pa2, pa3); partialSM(pA0, pA1, m_reg, mnA, alA);
    __syncthreads(); ATT_SWAIT(); ATT_SWRITE(1, SO);
    ATT_RESC(alA); __syncthreads();
  }
  ATT_SBAR(); qkt(pB0, pB1, K_lds + SHM_K, qr, r32, hi);
  finishSM(pA0, pA1, alA, l_reg, pa0, pa1, pa2, pa3); ATT_SBAR();
  pv_d0(o, vb0, pa0, pa1, pa2, pa3); partialSM(pB0, pB1, m_reg, mnB, alB);
  __syncthreads(); ATT_RESC(alB);
  finishSM(pB0, pB1, alB, l_reg, pa0, pa1, pa2, pa3); ATT_SBAR();
  pv_d0(o, vb0 + SHM_V, pa0, pa1, pa2, pa3);
  if (hi == 0) li_l[r32] = l_reg; asm volatile("s_waitcnt lgkmcnt(0)" ::: "memory");
  float rli[16];
#pragma unroll
  for (int r = 0; r < 16; ++r) rli[r] = __builtin_amdgcn_rcpf(li_l[crow(r, hi)]);
  float* tw = tmp + (size_t)(wid * QBLK) * 128;
  if constexpr (STREAM == 0) {
#pragma unroll
    for (int r = 0; r < 16; ++r) { const int orow = crow(r, hi);
#pragma unroll
      for (int d0 = 0; d0 < 4; ++d0) tw[orow * 128 + d0 * 32 + r32] = o[d0][r] * rli[r]; }
  } else {
    float sg[4];
#pragma unroll
    for (int d0 = 0; d0 < 4; ++d0) sg[d0] = subg[d0 * 32 + r32] * oscale;
    bf16* Ow = Ob + (size_t)(wid * QBLK) * 1024;
#pragma unroll
    for (int r = 0; r < 16; ++r) { const int orow = crow(r, hi); float v[4]; float ss = 0.f;
#pragma unroll
      for (int d0 = 0; d0 < 4; ++d0) { v[d0] = tw[orow * 128 + d0 * 32 + r32] - lam * (o[d0][r] * rli[r]); ss += v[d0] * v[d0]; }
#pragma unroll
      for (int of = 1; of < 32; of <<= 1) ss += __shfl_xor(ss, of);
      const float rs = rsqrtf(ss * (1.f / 128.f) + 1e-5f);
#pragma unroll
      for (int d0 = 0; d0 < 4; ++d0) { const unsigned w = cvtpk(v[d0] * rs * sg[d0], 0.f); Ow[(size_t)orow * 1024 + d0 * 32 + r32] = (bf16)(w & 0xffffu); } }
  }
#undef ATT_KROW
#undef ATT_SLOAD
#undef ATT_SWRITE
#undef ATT_SWAIT
#undef ATT_RESC
}
}

#ifndef MK_SPLIT
#define MK_SPLIT 0
#endif
constexpr int DM = 2048, NB = 8, SEQ = 4096, CTXL = 256, DEPTH = 4, BW = 1024;
constexpr int ML = NB * SEQ, MC = NB * CTXL, MT = ML + MC;
constexpr int DIN = 13696, N1 = 4608, N2 = 3072, N3 = 6144, NLR = 5120, KLR = 384, DFF = 5632, NFI = 2 * DFF, NMODC = 6 * DM;
constexpr int NWAVES = 8, NTHR = 512;
constexpr int N_IN = 28;
enum { I_X = 0, I_C, I_CTX, I_CCTX, I_WADA, I_BADA, I_NORMG, I_WIN, I_CONV, I_DW0, I_DUP, I_A0, I_AUP, I_GUP, I_KK, I_KA, I_RK, I_LNW, I_LNB, I_POOLW, I_POOLS, I_LAMQK, I_SUBG, I_WBR, I_WOUT, I_WFI, I_WFO, I_FING };

constexpr size_t MiB = 1u << 20;
constexpr size_t WS_CTL = 0, CTL_ZERO_BYTES = 1 * MiB;
constexpr size_t WS_MODS = 1 * MiB;
constexpr size_t WS_MISC = 3 * MiB;
constexpr size_t WS_W1T = 4 * MiB;
constexpr size_t WS_W2T = WS_W1T + (size_t)N1 * DM * 2;
constexpr size_t WS_W3T = WS_W2T + (size_t)N2 * DM * 2;
constexpr size_t WS_WLRT = WS_W3T + (size_t)N3 * DM * 2;
constexpr size_t WS_WBT = WS_WLRT + (size_t)NLR * KLR * 2;
constexpr size_t WS_WOT = WS_WBT + (size_t)3 * DM * BW * 2;
constexpr size_t WS_WFIT = WS_WOT + (size_t)DM * DM * 2;
constexpr size_t WS_WFOT = WS_WFIT + (size_t)NFI * DM * 2;
constexpr size_t WS_H = WS_WFOT + (size_t)DM * DFF * 2;
constexpr size_t WS_Z = WS_H + (size_t)MT * DM * 2;
constexpr size_t WS_RKV = WS_Z + (size_t)MT * N3 * 2;
constexpr size_t WS_LR = WS_RKV + (size_t)MT * 3072 * 2;
constexpr size_t WS_Y2 = WS_LR + (size_t)MT * NLR * 2;
constexpr size_t WS_POOL = WS_Y2 + (size_t)2 * MT * BW * 2;
constexpr size_t WS_YA = WS_POOL + (size_t)MT * BW * 2;
constexpr size_t WS_YC = WS_YA + (size_t)MT * BW * 2;
constexpr size_t WS_XC = WS_YC + (size_t)MT * BW * 2;
constexpr size_t WS_ATMP = WS_XC + (size_t)MC * DM * 4;
constexpr size_t WS_END = WS_ATMP + (size_t)256 * 256 * 128 * 4;
static_assert(WS_W1T % 256 == 0 && WS_H % 256 == 0 && WS_Z % 256 == 0 && WS_LR % 256 == 0 && WS_ATMP % 256 == 0, "alignment");
static_assert((size_t)MT * DM * 2 <= (size_t)MT * 3072 * 2, "accb (bf16 [MT][2048]) aliases the post-conv r|k|v buffer");
constexpr int CW_BAR = 4096;

constexpr int RING_BYTES = 131072, LDSCTL_OFF = RING_BYTES, MISC_OFF = LDSCTL_OFF + 320, LDS_BYTES = 147456;

#define GAS __attribute__((address_space(1)))
#define LAS __attribute__((address_space(3)))
typedef unsigned short bf16;
typedef unsigned v4u __attribute__((ext_vector_type(4)));
typedef unsigned v2u __attribute__((ext_vector_type(2)));
typedef float f32x4 __attribute__((ext_vector_type(4)));
typedef float f32x2v __attribute__((ext_vector_type(2)));
typedef _Float16 h2 __attribute__((ext_vector_type(2)));
#define LDS_WAIT() asm volatile("s_waitcnt lgkmcnt(0)" ::: "memory")
#define WG_BAR_LDS() do { asm volatile("s_waitcnt lgkmcnt(0)" ::: "memory"); __builtin_amdgcn_s_barrier(); asm volatile("" ::: "memory"); } while (0)
__device__ __forceinline__ unsigned f2bf(float f) { unsigned u = __builtin_bit_cast(unsigned, f); return (u + 0x7fffu + ((u >> 16) & 1u)) >> 16; }
__device__ __forceinline__ unsigned pk2(float lo, float hi) { return f2bf(lo) | (f2bf(hi) << 16); }
__device__ __forceinline__ float bflo(unsigned w) { return __uint_as_float(w << 16); }
__device__ __forceinline__ float bfhi(unsigned w) { return __uint_as_float(w & 0xffff0000u); }

__device__ __forceinline__ int opaque_s(int x) { asm volatile("" : "+s"(x)); return x; }
__device__ __forceinline__ int opaque_tid(int wave_s) { int t = (wave_s << 6) | lane_id_asm(); asm volatile("" : "+v"(t)); return t; }

#define XB_TMO      128
#define XB_XCNT(j)  (256  + 64 * (j))
#define XB_XSUB(j)  (1280 + 64 * (j))
#define XB_XGEN(j)  (2304 + 64 * (j))
#define XB_TOP      3328
#define XB_TOPGEN   3392
#define XCD_BAR_WORDS 3456
#define XB_SPIN_CAP (1u << 18)

__device__ __forceinline__ unsigned xb_ld(unsigned* p)              { return __hip_atomic_load(p, __ATOMIC_RELAXED, __HIP_MEMORY_SCOPE_AGENT); }
__device__ __forceinline__ unsigned xb_add(unsigned* p, unsigned v) { return __hip_atomic_fetch_add(p, v, __ATOMIC_RELAXED, __HIP_MEMORY_SCOPE_AGENT); }
__device__ __forceinline__ unsigned xb_xcc_id() { return (unsigned)__builtin_amdgcn_s_getreg((3 << 11) | 20) & 0xFu; }
#define XB_SPIN(cond, bar) do { unsigned _sp = 0; while (cond) { __builtin_amdgcn_s_sleep(1); \
    if ((++_sp & 255u) == 0u) { if (xb_ld(&(bar)[XB_TMO])) break; if (_sp > XB_SPIN_CAP) { atomicAdd(&(bar)[XB_TMO], 1u); break; } } } } while (0)

struct XcdBarrier {
    unsigned* bar; unsigned x;
    volatile LAS unsigned* st;
};

__device__ __forceinline__ XcdBarrier xcd_barrier_post(unsigned* bar, volatile LAS unsigned* st, bool t0  ) {
    XcdBarrier b; b.bar = bar; b.x = xb_xcc_id(); b.st = st;
    if (t0) (void)xb_add(&bar[XB_XCNT(b.x)], 1u);
    return b;
}
__device__ __forceinline__ void xcd_barrier_complete(unsigned* bar, unsigned x, unsigned& nloc, unsigned& nx) {
    const unsigned G = gridDim.x * gridDim.y * gridDim.z;
    unsigned sum, cnt, mine, sp = 0u;
    for (;;) {
        sum = 0u; cnt = 0u; mine = 0u;
#pragma unroll
        for (unsigned j = 0; j < 16; ++j) { const unsigned c = xb_ld(&bar[XB_XCNT(j)]); sum += c; cnt += (c > 0u) ? 1u : 0u; mine = (j == x) ? c : mine; }
        if (sum == G) break;
        __builtin_amdgcn_s_sleep(1);
        if ((++sp & 255u) == 0u) { if (xb_ld(&bar[XB_TMO])) break; if (sp > XB_SPIN_CAP) { atomicAdd(&bar[XB_TMO], 1u); break; } }
    }
    nloc = mine > 0u ? mine : 1u; nx = cnt > 0u ? cnt : 1u;
}

__device__ __forceinline__ void xcd_barrier(const XcdBarrier& b, bool t0  ) {
    asm volatile("s_waitcnt vmcnt(0)" ::: "memory");
    __syncthreads();
    if (t0) {
        unsigned* bar = b.bar;
        __builtin_amdgcn_s_waitcnt(0);
        unsigned nloc = b.st[0], nx = b.st[1];
        if (nloc == 0u) { xcd_barrier_complete(bar, b.x, nloc, nx); b.st[0] = nloc; b.st[1] = nx; }
        const unsigned old = xb_add(&bar[XB_XSUB(b.x)], 1u);
        const unsigned gen = old / nloc;
        if (old + 1u == (gen + 1u) * nloc) {
            __builtin_amdgcn_fence(__ATOMIC_RELEASE, "agent");
            asm volatile("s_waitcnt vmcnt(0)" ::: "memory");
            const unsigned og = xb_add(&bar[XB_TOP], 1u);
            const unsigned tg = og / nx;
            if (og + 1u == (tg + 1u) * nx) xb_add(&bar[XB_TOPGEN], 1u);
            else XB_SPIN(xb_ld(&bar[XB_TOPGEN]) == tg, bar);
            __builtin_amdgcn_fence(__ATOMIC_ACQUIRE, "agent");
            xb_add(&bar[XB_XGEN(b.x)], 1u);
            asm volatile("s_waitcnt vmcnt(0)" ::: "memory");
        } else {
            XB_SPIN(xb_ld(&bar[XB_XGEN(b.x)]) == gen, bar);
            __builtin_amdgcn_fence(__ATOMIC_ACQUIRE, "agent");
            asm volatile("s_waitcnt vmcnt(0)" ::: "memory");
        }
    }
    __syncthreads();
}

struct Ctx {
    unsigned char* lds;
    int vcu, G, wave_s;
    const float* const __attribute__((address_space(4)))* ka;
    float* out; unsigned char* ws;
    __device__ __forceinline__ const float* inp(int i) const { const float* const __attribute__((address_space(4)))* p = ka; asm volatile("" : "+s"(p)); return p[i]; }
};

__device__ __forceinline__ void ph_mods(const Ctx& C) {
    const int tid = opaque_tid(C.wave_s), lane = tid & 63, wave = __builtin_amdgcn_readfirstlane(tid >> 6), cG = opaque_s(C.G), cvcu = opaque_s(C.vcu); (void)lane; (void)wave; (void)cG; (void)cvcu;

    float* sc = (float*)C.lds;
    float* red = sc + 9 * 2048;
    float* mods = (float*)(C.ws + WS_MODS);
    for (int i = tid; i < 9 * 2048; i += NTHR) { const int r = i >> 11, k = i & 2047; const float v = r < 8 ? C.inp(I_C)[r * 2048 + k] : C.inp(I_CCTX)[k]; sc[i] = v / (1.f + expf(-v)); }
    __syncthreads();
    for (int it = blockIdx.x; it < DEPTH * (NMODC / 64); it += gridDim.x) {
        const int l = it / (NMODC / 64), nb = it % (NMODC / 64);
        const float* W = C.inp(I_WADA) + (size_t)l * DM * NMODC + nb * 64 + lane;
        float acc[9];
#pragma unroll
        for (int r = 0; r < 9; ++r) acc[r] = 0.f;
        const int kbeg = wave * 256;
#pragma unroll 4
        for (int k4 = 0; k4 < 64; ++k4) { const int k = kbeg + 4 * k4;
            const float w0 = W[(size_t)k * NMODC], w1 = W[(size_t)(k + 1) * NMODC], w2 = W[(size_t)(k + 2) * NMODC], w3 = W[(size_t)(k + 3) * NMODC];
#pragma unroll
            for (int r = 0; r < 9; ++r) { const f32x4 s = *(const f32x4*)(sc + r * 2048 + k); acc[r] += s.x * w0 + s.y * w1 + s.z * w2 + s.w * w3; } }
#pragma unroll
        for (int r = 0; r < 9; ++r) red[(wave * 9 + r) * 64 + lane] = acc[r];
        __syncthreads();
        for (int i = tid; i < 9 * 64; i += NTHR) { const int r = i >> 6, cc = i & 63; float s = 0.f;
#pragma unroll
            for (int w = 0; w < 8; ++w) s += red[(w * 9 + r) * 64 + cc];
            mods[((size_t)l * 9 + r) * NMODC + nb * 64 + cc] = s + C.inp(I_BADA)[l * NMODC + nb * 64 + cc]; }
        __syncthreads();
    }
    if (blockIdx.x == 0) {
        float* cosT = (float*)(C.ws + WS_MISC); float* sinT = cosT + 1024; float* lamv = sinT + 1024;
        for (int i = tid; i < 1024; i += NTHR) { const int pos = i >> 4, f = i & 15; const float inv = powf(10000.0f, -(float)f / 16.0f), ang = (float)pos * inv; cosT[i] = cosf(ang); sinT[i] = sinf(ang); }
        if (tid < DEPTH) { const float* lq = C.inp(I_LAMQK) + tid * 256; float d0 = 0.f, d1 = 0.f;
            for (int i = 0; i < 64; ++i) { d0 += lq[i] * lq[64 + i]; d1 += lq[128 + i] * lq[192 + i]; }
            const float lam_init = 0.8f - 0.6f * expf(-0.3f * (float)tid);
            lamv[tid] = expf(d0) - expf(d1) + lam_init; }
    }
}

__device__ __forceinline__ void ph_norm(const Ctx& C, int l, int which, int Mrows) {
    const int tid = opaque_tid(C.wave_s), lane = tid & 63, wave = __builtin_amdgcn_readfirstlane(tid >> 6), cG = opaque_s(C.G), cvcu = opaque_s(C.vcu); (void)lane; (void)wave; (void)cG; (void)cvcu;

    const int gw = cvcu * NWAVES + wave, NGW = cG * NWAVES;
    const float* g = C.inp(I_NORMG) + (l * 2 + which) * DM;
    const float* mods = (const float*)(C.ws + WS_MODS) + (size_t)l * 9 * NMODC;
    const bool first = (l == 0 && which == 0);
    bf16* H = (bf16*)(C.ws + WS_H);
    f32x4 gv[8];
#pragma unroll
    for (int j = 0; j < 8; ++j) gv[j] = *(const f32x4*)(g + 4 * lane + 256 * j);
    for (int m = gw; m < Mrows; m += NGW) {
        const float* xr; int r;
        if (m < ML) { xr = (first ? C.inp(I_X) : C.out) + (size_t)m * DM; r = m >> 12; } else { xr = (first ? C.inp(I_CTX) : (const float*)(C.ws + WS_XC)) + (size_t)(m - ML) * DM; r = 8; }
        const float* shift = mods + (size_t)r * NMODC + (which ? 3 : 0) * DM; const float* scale = mods + (size_t)r * NMODC + (which ? 4 : 1) * DM;
        f32x4 v[8]; float s = 0.f;
#pragma unroll
        for (int j = 0; j < 8; ++j) { v[j] = *(const f32x4*)(xr + 4 * lane + 256 * j); s += (v[j].x * v[j].x + v[j].y * v[j].y) + (v[j].z * v[j].z + v[j].w * v[j].w); }
#pragma unroll
        for (int o = 1; o < 64; o <<= 1) s += __shfl_xor(s, o);
        const float rstd = rsqrtf(s * (1.f / DM) + 1e-6f);
        unsigned long long* o8 = (unsigned long long*)(H + (size_t)m * DM) + lane;
#pragma unroll
        for (int j = 0; j < 8; ++j) { const f32x4 sh = *(const f32x4*)(shift + 4 * lane + 256 * j), scv = *(const f32x4*)(scale + 4 * lane + 256 * j);
            const f32x4 y = (v[j] * rstd) * gv[j] * (scv + 1.0f) + sh;
            o8[64 * j] = (unsigned long long)pk2(y.x, y.y) | ((unsigned long long)pk2(y.z, y.w) << 32); }
    }
}
__device__ __forceinline__ void ph_final(const Ctx& C) {
    const int tid = opaque_tid(C.wave_s), lane = tid & 63, wave = __builtin_amdgcn_readfirstlane(tid >> 6), cG = opaque_s(C.G), cvcu = opaque_s(C.vcu); (void)lane; (void)wave; (void)cG; (void)cvcu;

    const int gw = cvcu * NWAVES + wave, NGW = cG * NWAVES;
    const float* g = C.inp(I_FING);
    for (int m = gw; m < ML; m += NGW) {
        float* xr = C.out + (size_t)m * DM; f32x4 v[8]; float s = 0.f;
#pragma unroll
        for (int j = 0; j < 8; ++j) { v[j] = *(const f32x4*)(xr + 4 * lane + 256 * j); s += (v[j].x * v[j].x + v[j].y * v[j].y) + (v[j].z * v[j].z + v[j].w * v[j].w); }
#pragma unroll
        for (int o = 1; o < 64; o <<= 1) s += __shfl_xor(s, o);
        const float rstd = rsqrtf(s * (1.f / DM) + 1e-6f);
#pragma unroll
        for (int j = 0; j < 8; ++j) { const f32x4 gv = *(const f32x4*)(g + 4 * lane + 256 * j); *(f32x4*)(xr + 4 * lane + 256 * j) = (v[j] * rstd) * gv; }
    }
}

template <class SrcFn>
__device__ __forceinline__ void tr_item(const float* W, int ldw, int ksrc0, const SrcFn& src, bf16* WT, int ldt, int n0, int kdst0, float* scr, int lane) {
    const int scol = src(n0 + (lane & 31));
#pragma unroll 8
    for (int i = 0; i < 32; ++i) { const int kk = 2 * i + (lane >> 5); scr[kk * 33 + (lane & 31)] = scol >= 0 ? W[(size_t)(ksrc0 + kk) * ldw + scol] : 0.f; }
    LDS_WAIT();
    const int c = lane & 7;
#pragma unroll
    for (int j = 0; j < 4; ++j) { const int n = (lane >> 3) + 8 * j; const float* s = scr + (8 * c) * 33 + n;
        v4u o; o.x = pk2(s[0 * 33], s[1 * 33]); o.y = pk2(s[2 * 33], s[3 * 33]); o.z = pk2(s[4 * 33], s[5 * 33]); o.w = pk2(s[6 * 33], s[7 * 33]);
        *(v4u*)(WT + (size_t)(n0 + n) * ldt + kdst0 + 8 * c) = o; }
    LDS_WAIT();
}
struct SrcOff { int off, lim; __device__ __forceinline__ int operator()(int n) const { return n < lim ? off + n : -1; } };
struct SrcQkv { __device__ __forceinline__ int operator()(int n) const {
    if (n >= 2048) return 6528 + (n - 2048); const int G = n >> 5, w = n & 31, u = w >> 3, nn = (w >> 2) & 1, j = w & 3; return 4480 + 32 * G + 16 * nn + 4 * u + j; } };
struct SrcFfi { __device__ __forceinline__ int operator()(int n) const { const int pn = n >> 8, bj = (n >> 7) & 1, c = n & 127; return bj * DFF + 128 * pn + c; } };

__device__ __forceinline__ void ph_wprep(const Ctx& C, int l) {
    const int tid = opaque_tid(C.wave_s), lane = tid & 63, wave = __builtin_amdgcn_readfirstlane(tid >> 6), cG = opaque_s(C.G), cvcu = opaque_s(C.vcu); (void)lane; (void)wave; (void)cG; (void)cvcu;

    float* scr = (float*)(C.lds + wave * 16384);
    const int gw = cvcu * NWAVES + wave, NGW = cG * NWAVES;
    const float* win = C.inp(I_WIN) + (size_t)l * DM * DIN;
    constexpr int I1 = 32 * (N1 / 32), I2 = 32 * (N2 / 32), I3 = 32 * (N3 / 32), ILR = 6 * (NLR / 32), IB = 16 * 64, IO = 32 * 64, IFI = 32 * (NFI / 32), IFO = 88 * 64;
    constexpr int NITEMS = I1 + I2 + I3 + ILR + 2 * IB + IO + IFI + IFO;
    for (int it = gw; it < NITEMS; it += NGW) {
        int r = it;
        if (r < I1) { const int kb = r / (N1 / 32), nb = r % (N1 / 32); tr_item(win, DIN, 64 * kb, SrcOff{0, 4480}, (bf16*)(C.ws + WS_W1T), DM, 32 * nb, 64 * kb, scr, lane); continue; } r -= I1;
        if (r < I2) { const int kb = r / (N2 / 32), nb = r % (N2 / 32); tr_item(win, DIN, 64 * kb, SrcQkv{}, (bf16*)(C.ws + WS_W2T), DM, 32 * nb, 64 * kb, scr, lane); continue; } r -= I2;
        if (r < I3) { const int kb = r / (N3 / 32), nb = r % (N3 / 32); tr_item(win, DIN, 64 * kb, SrcOff{7552, N3}, (bf16*)(C.ws + WS_W3T), DM, 32 * nb, 64 * kb, scr, lane); continue; } r -= I3;
        if (r < ILR) { const int kb = r / (NLR / 32), nb = r % (NLR / 32), n0 = 32 * nb, reg = n0 >> 10;
            const bool valid = reg < 4 ? (kb == reg) : (kb >= 4);
            const float* W = reg < 2 ? C.inp(I_DUP) + (size_t)(l * 2 + reg) * 64 * BW : reg < 4 ? C.inp(I_AUP) + (size_t)(l * 2 + reg - 2) * 64 * BW : C.inp(I_GUP) + (size_t)l * 128 * BW;
            const int ks = reg < 4 ? 0 : 64 * (kb - 4);
            tr_item(W, BW, ks, SrcOff{valid ? -(reg << 10) : -(1 << 30), valid ? (1 << 30) : 0}, (bf16*)(C.ws + WS_WLRT), KLR, n0, 64 * kb, scr, lane); continue; } r -= ILR;
        if (r < 2 * IB) { const int i = r / IB ? 2 : 0, q = r % IB, kb = q / 64, nb = q % 64;
            tr_item(C.inp(I_WBR) + (size_t)(l * 3 + i) * BW * DM, DM, 64 * kb, SrcOff{0, DM}, (bf16*)(C.ws + WS_WBT) + (size_t)i * DM * BW, BW, 32 * nb, 64 * kb, scr, lane); continue; } r -= 2 * IB;
        if (r < IO) { const int kb = r / 64, nb = r % 64; tr_item(C.inp(I_WOUT) + (size_t)l * DM * DM, DM, 64 * kb, SrcOff{0, DM}, (bf16*)(C.ws + WS_WOT), DM, 32 * nb, 64 * kb, scr, lane); continue; } r -= IO;
        if (r < IFI) { const int kb = r / (NFI / 32), nb = r % (NFI / 32); tr_item(C.inp(I_WFI) + (size_t)l * DM * NFI, NFI, 64 * kb, SrcFfi{}, (bf16*)(C.ws + WS_WFIT), DM, 32 * nb, 64 * kb, scr, lane); continue; } r -= IFI;
        { const int kb = r / 64, nb = r % 64; tr_item(C.inp(I_WFO) + (size_t)l * DFF * DM, DM, 64 * kb, SrcOff{0, DM}, (bf16*)(C.ws + WS_WFOT), DFF, 32 * nb, 64 * kb, scr, lane); }
    }
    __syncthreads();
    { float* wbs = (float*)C.lds;
      const float* wb1 = C.inp(I_WBR) + (size_t)(l * 3 + 1) * BW * DM; bf16* WT = (bf16*)(C.ws + WS_WBT) + (size_t)1 * DM * BW;
      for (int it = blockIdx.x; it < 256; it += gridDim.x) { const int g = it >> 6, n0 = (it & 63) * 32;
          for (int i = tid; i < 8192; i += NTHR) { const int d = i >> 5, nn = i & 31; wbs[i] = C.inp(I_POOLS)[l * BW + g * 256 + d] * wb1[(size_t)(g * 256 + d) * DM + n0 + nn]; }
          __syncthreads();
          const int c = tid & 255, nh = tid >> 8; const float* pw = C.inp(I_POOLW) + ((size_t)(l * 4 + g) * 256 + c) * 256;
          float acc[16];
#pragma unroll
          for (int j = 0; j < 16; ++j) acc[j] = 0.f;
          for (int d4 = 0; d4 < 64; ++d4) { const f32x4 p = *(const f32x4*)(pw + 4 * d4);
#pragma unroll
              for (int q = 0; q < 4; ++q) { const float pv = p[q]; const float* wr = wbs + (4 * d4 + q) * 32 + 16 * nh;
#pragma unroll
                  for (int j4 = 0; j4 < 4; ++j4) { const f32x4 w = *(const f32x4*)(wr + 4 * j4); acc[4 * j4] += pv * w.x; acc[4 * j4 + 1] += pv * w.y; acc[4 * j4 + 2] += pv * w.z; acc[4 * j4 + 3] += pv * w.w; } } }
#pragma unroll
          for (int j = 0; j < 16; ++j) WT[(size_t)(n0 + 16 * nh + j) * BW + g * 256 + c] = (bf16)f2bf(acc[j]);
          __syncthreads(); } }
}

__device__ __forceinline__ void ph_convpool(const Ctx& C, int l) {
    const int tid = opaque_tid(C.wave_s), lane = tid & 63, wave = __builtin_amdgcn_readfirstlane(tid >> 6), cG = opaque_s(C.G), cvcu = opaque_s(C.vcu); (void)lane; (void)wave; (void)cG; (void)cvcu;

    const bf16* z1 = (const bf16*)(C.ws + WS_Z); bf16* rkv = (bf16*)(C.ws + WS_RKV); bf16* pooled = (bf16*)(C.ws + WS_POOL);
    const int per = (MT + cG - 1) / cG, m0 = cvcu * per, m1 = (m0 + per < MT) ? m0 + per : MT;
    if (tid < 384) {
        const int col = tid * 8; const float* cw = C.inp(I_CONV) + (size_t)l * 3 * 3072 + col;
        float w[3][8];
#pragma unroll
        for (int j = 0; j < 3; ++j) { const f32x4 a = *(const f32x4*)(cw + j * 3072), b = *(const f32x4*)(cw + j * 3072 + 4); w[j][0] = a.x; w[j][1] = a.y; w[j][2] = a.z; w[j][3] = a.w; w[j][4] = b.x; w[j][5] = b.y; w[j][6] = b.z; w[j][7] = b.w; }
        int m = m0;
        for (; m + 8 <= m1; m += 8) {
            const int t0 = m < ML ? (m & 4095) : ((m - ML) & 255), n = m < ML ? SEQ : CTXL;
            v4u z[10];
#pragma unroll
            for (int r = 0; r < 10; ++r) { int mr = m - 1 + r; mr = mr < 0 ? 0 : (mr > MT - 1 ? MT - 1 : mr); z[r] = *(const v4u*)(z1 + (size_t)mr * N1 + col); }
#pragma unroll
            for (int r = 0; r < 8; ++r) { const bool hp = (t0 + r > 0), hn = (t0 + r < n - 1); v4u o;
#pragma unroll
                for (int q = 0; q < 4; ++q) { const unsigned zpq = hp ? z[r][q] : 0u, znq = hn ? z[r + 2][q] : 0u, zcq = z[r + 1][q];
                    const float lo = w[0][2 * q] * bflo(zpq) + w[1][2 * q] * bflo(zcq) + w[2][2 * q] * bflo(znq);
                    const float hi = w[0][2 * q + 1] * bfhi(zpq) + w[1][2 * q + 1] * bfhi(zcq) + w[2][2 * q + 1] * bfhi(znq); o[q] = pk2(lo, hi); }
                *(v4u*)(rkv + (size_t)(m + r) * 3072 + col) = o; }
        }
        for (; m < m1; ++m) {
            const int t = m < ML ? (m & 4095) : ((m - ML) & 255), n = m < ML ? SEQ : CTXL;
            const v4u zc = *(const v4u*)(z1 + (size_t)m * N1 + col);
            v4u zp = (v4u){0u, 0u, 0u, 0u}, zn = (v4u){0u, 0u, 0u, 0u};
            if (t > 0) zp = *(const v4u*)(z1 + (size_t)(m - 1) * N1 + col);
            if (t < n - 1) zn = *(const v4u*)(z1 + (size_t)(m + 1) * N1 + col);
            v4u o;
#pragma unroll
            for (int q = 0; q < 4; ++q) { const float lo = w[0][2 * q] * bflo(zp[q]) + w[1][2 * q] * bflo(zc[q]) + w[2][2 * q] * bflo(zn[q]);
                const float hi = w[0][2 * q + 1] * bfhi(zp[q]) + w[1][2 * q + 1] * bfhi(zc[q]) + w[2][2 * q + 1] * bfhi(zn[q]); o[q] = pk2(lo, hi); }
            *(v4u*)(rkv + (size_t)m * 3072 + col) = o;
        }
    } else {
        const int col = (tid - 384) * 8, gi = col >> 8, half = 1 << gi;
        float s[8];
#pragma unroll
        for (int q = 0; q < 8; ++q) s[q] = 0.f;
        int m = m0;
        for (; m + 8 <= m1; m += 8) {
            const int t0 = m < ML ? (m & 4095) : ((m - ML) & 255), n = m < ML ? SEQ : CTXL;
            const bf16* zb = z1 + (size_t)(m - t0) * N1 + 3456 + col;
            v4u zi[8], zo[8], zc[8];
#pragma unroll
            for (int r = 0; r < 8; ++r) { const int t = t0 + r; int ti = t - 1 + half, to = t - 1 - half; ti = ti > n - 1 ? n - 1 : ti; to = to < 0 ? 0 : to;
                zi[r] = *(const v4u*)(zb + (size_t)ti * N1); zo[r] = *(const v4u*)(zb + (size_t)to * N1); zc[r] = *(const v4u*)(zb + (size_t)t * N1); }
            if (m == m0 || t0 == 0) {
                const int lo = t0 - half > 0 ? t0 - half : 0, hi = t0 + half < n ? t0 + half : n;
#pragma unroll
                for (int q = 0; q < 8; ++q) s[q] = 0.f;
                for (int tt = lo; tt < hi; ++tt) { const v4u z = *(const v4u*)(zb + (size_t)tt * N1);
#pragma unroll
                    for (int q = 0; q < 4; ++q) { s[2 * q] += bflo(z[q]); s[2 * q + 1] += bfhi(z[q]); } }
            } else {
                const bool vi = (t0 - 1 + half < n), vo = (t0 - 1 - half >= 0);
#pragma unroll
                for (int q = 0; q < 4; ++q) { const unsigned a = vi ? zi[0][q] : 0u, b2 = vo ? zo[0][q] : 0u; s[2 * q] += bflo(a) - bflo(b2); s[2 * q + 1] += bfhi(a) - bfhi(b2); }
            }
#pragma unroll
            for (int r = 0; r < 8; ++r) { const int t = t0 + r;
                if (r > 0) { const bool vi = (t - 1 + half < n), vo = (t - 1 - half >= 0);
#pragma unroll
                    for (int q = 0; q < 4; ++q) { const unsigned a = vi ? zi[r][q] : 0u, b2 = vo ? zo[r][q] : 0u; s[2 * q] += bflo(a) - bflo(b2); s[2 * q + 1] += bfhi(a) - bfhi(b2); } }
                const int lo = t - half > 0 ? t - half : 0, hi = t + half < n ? t + half : n; const float inv = 1.f / (float)(hi - lo);
                v4u o;
#pragma unroll
                for (int q = 0; q < 4; ++q) o[q] = pk2(s[2 * q] * inv - bflo(zc[r][q]), s[2 * q + 1] * inv - bfhi(zc[r][q]));
                *(v4u*)(pooled + (size_t)(m + r) * BW + col) = o; }
        }
        for (; m < m1; ++m) {
            const int t = m < ML ? (m & 4095) : ((m - ML) & 255), n = m < ML ? SEQ : CTXL;
            const bf16* zb = z1 + (size_t)(m - t) * N1 + 3456 + col;
            const int lo = t - half > 0 ? t - half : 0, hi = t + half < n ? t + half : n;
            if (m == m0 || t == 0) {
#pragma unroll
                for (int q = 0; q < 8; ++q) s[q] = 0.f;
                for (int tt = lo; tt < hi; ++tt) { const v4u z = *(const v4u*)(zb + (size_t)tt * N1);
#pragma unroll
                    for (int q = 0; q < 4; ++q) { s[2 * q] += bflo(z[q]); s[2 * q + 1] += bfhi(z[q]); } }
            } else {
                v4u zin = (v4u){0u, 0u, 0u, 0u}, zout = (v4u){0u, 0u, 0u, 0u};
                if (t - 1 + half < n) zin = *(const v4u*)(zb + (size_t)(t - 1 + half) * N1);
                if (t - 1 - half >= 0) zout = *(const v4u*)(zb + (size_t)(t - 1 - half) * N1);
#pragma unroll
                for (int q = 0; q < 4; ++q) { s[2 * q] += bflo(zin[q]) - bflo(zout[q]); s[2 * q + 1] += bfhi(zin[q]) - bfhi(zout[q]); }
            }
            const v4u zc = *(const v4u*)(zb + (size_t)t * N1); const float inv = 1.f / (float)(hi - lo);
            v4u o;
#pragma unroll
            for (int q = 0; q < 4; ++q) o[q] = pk2(s[2 * q] * inv - bflo(zc[q]), s[2 * q + 1] * inv - bfhi(zc[q]));
            *(v4u*)(pooled + (size_t)m * BW + col) = o;
        }
    }
}
__device__ __forceinline__ float fsigmoid(float x) { return __builtin_amdgcn_rcpf(1.0f + __expf(-x)); }
__device__ __forceinline__ float red8(float x) {
    x += __builtin_bit_cast(float, __builtin_amdgcn_update_dpp(0, __builtin_bit_cast(int, x), 0xB1, 0xF, 0xF, true));
    x += __builtin_bit_cast(float, __builtin_amdgcn_update_dpp(0, __builtin_bit_cast(int, x), 0x4E, 0xF, 0xF, true));
    x += __builtin_bit_cast(float, __builtin_amdgcn_update_dpp(0, __builtin_bit_cast(int, x), 0x141, 0xF, 0xF, true));
    return x;
}
__device__ __forceinline__ void ph_scan(const Ctx& C, int l) {
    float* op = (float*)C.lds;
    float* yb = op + 16 * 384;
    const bf16* rkv = (const bf16*)(C.ws + WS_RKV); const _Float16* lr = (const _Float16*)(C.ws + WS_LR); bf16* ydir = (bf16*)(C.ws + WS_Y2);
    const int tid = opaque_tid(C.wave_s), lane = tid & 63, wv = __builtin_amdgcn_readfirstlane(tid >> 6), ss = tid >> 5, cp = tid & 31;
    const int vl = lane >> 3, kq = lane & 7;
    for (int it = blockIdx.x; it < 256; it += gridDim.x) {
        const int b = it >> 5, h = (it >> 1) & 15, dir = it & 1, ch = h * 64 + 2 * cp;
        const float kks0 = C.inp(I_KK)[l * BW + ch], kks1 = C.inp(I_KK)[l * BW + ch + 1], ka0 = C.inp(I_KA)[l * BW + ch], ka1 = C.inp(I_KA)[l * BW + ch + 1];
        const float dw0 = C.inp(I_DW0)[(l * 2 + dir) * BW + ch], dw1 = C.inp(I_DW0)[(l * 2 + dir) * BW + ch + 1], ia0 = C.inp(I_A0)[(l * 2 + dir) * BW + ch], ia1 = C.inp(I_A0)[(l * 2 + dir) * BW + ch + 1];
        f32x2v S[4];
#pragma unroll
        for (int i = 0; i < 4; ++i) S[i] = (f32x2v){0.f, 0.f};
        unsigned rr, rk, rv; h2 rs, ra;
#define SCAN_ROW(g) ((g) < 256 ? (ML + b * 256 + (dir ? 255 - (g) : (g))) : (b * 4096 + (dir ? 4095 - ((g) - 256) : ((g) - 256))))
#define SCAN_LOAD(c) do { const size_t _row = (size_t)SCAN_ROW(16 * (c) + ss); rr = *(const unsigned*)(rkv + _row * 3072 + ch); rk = *(const unsigned*)(rkv + _row * 3072 + 1024 + ch); rv = *(const unsigned*)(rkv + _row * 3072 + 2048 + ch); \
        rs = *(const h2*)(lr + _row * NLR + dir * 1024 + ch); ra = *(const h2*)(lr + _row * NLR + 2048 + dir * 1024 + ch); } while (0)
        SCAN_LOAD(0);
        for (int c = 0; c < 272; ++c) {
            { const float k0 = bflo(rk), k1 = bfhi(rk), q0 = k0 * kks0, q1 = k1 * kks1; float sq = q0 * q0 + q1 * q1;
#pragma unroll
              for (int o = 1; o < 32; o <<= 1) sq += __shfl_xor(sq, o);
              const float inv = __builtin_amdgcn_rsqf(fmaxf(sq, 1e-24f)), n0 = q0 * inv, n1 = q1 * inv;
              const float a0 = fsigmoid((float)ra[0] + ia0), a1 = fsigmoid((float)ra[1] + ia1);
              const float sd0 = fsigmoid((float)rs[0] + dw0), sd1 = fsigmoid((float)rs[1] + dw1);
              float* o = op + ss * 384 + 2 * cp;
              *(f32x2v*)(o) = (f32x2v){-n0, -n1};
              *(f32x2v*)(o + 64) = (f32x2v){__expf(-0.60653065971f * sd0), __expf(-0.60653065971f * sd1)};
              *(f32x2v*)(o + 128) = (f32x2v){n0 * a0, n1 * a1};
              *(f32x2v*)(o + 192) = (f32x2v){k0 * (1.f + (a0 - 1.f) * ka0), k1 * (1.f + (a1 - 1.f) * ka1)};
              *(f32x2v*)(o + 256) = (f32x2v){bflo(rr), bfhi(rr)};
              *(f32x2v*)(o + 320) = (f32x2v){bflo(rv), bfhi(rv)}; }
            if (c + 1 < 272) SCAN_LOAD(c + 1);
            WG_BAR_LDS();
#pragma unroll
            for (int s = 0; s < 16; ++s) {
                const float* o = op + s * 384 + 8 * kq;
                const f32x4 a0 = *(const f32x4*)(o), a1 = *(const f32x4*)(o + 4), w0 = *(const f32x4*)(o + 64), w1 = *(const f32x4*)(o + 68), b0 = *(const f32x4*)(o + 128), b1 = *(const f32x4*)(o + 132);
                const f32x4 d0 = *(const f32x4*)(o + 192), d1 = *(const f32x4*)(o + 196), r0 = *(const f32x4*)(o + 256), r1 = *(const f32x4*)(o + 260);
                const float vv = op[s * 384 + 320 + 8 * wv + vl];
#define SC_LO(q) ((f32x2v){(q).x, (q).y})
#define SC_HI(q) ((f32x2v){(q).z, (q).w})
                f32x2v pa = S[0] * SC_LO(a0); pa = S[1] * SC_HI(a0) + pa; pa = S[2] * SC_LO(a1) + pa; pa = S[3] * SC_HI(a1) + pa;
                const float sa = red8(pa.x + pa.y);
                const f32x2v sa2 = (f32x2v){sa, sa}, vv2 = (f32x2v){vv, vv};
                S[0] = S[0] * SC_LO(w0) + (sa2 * SC_LO(b0) + vv2 * SC_LO(d0)); S[1] = S[1] * SC_HI(w0) + (sa2 * SC_HI(b0) + vv2 * SC_HI(d0));
                S[2] = S[2] * SC_LO(w1) + (sa2 * SC_LO(b1) + vv2 * SC_LO(d1)); S[3] = S[3] * SC_HI(w1) + (sa2 * SC_HI(b1) + vv2 * SC_HI(d1));
                f32x2v py = S[0] * SC_LO(r0); py = S[1] * SC_HI(r0) + py; py = S[2] * SC_LO(r1) + py; py = S[3] * SC_HI(r1) + py;
                const float y = red8(py.x + py.y);
#undef SC_LO
#undef SC_HI
                if (kq == 0) yb[s * 64 + 8 * wv + vl] = y;
            }
            WG_BAR_LDS();
            { const f32x2v acc = *(const f32x2v*)(yb + ss * 64 + 2 * cp);
              const size_t row = (size_t)SCAN_ROW(16 * c + ss);
              *(unsigned*)(ydir + ((size_t)dir * MT + row) * BW + ch) = pk2(acc.x, acc.y); }
        }
        WG_BAR_LDS();
#undef SCAN_LOAD
#undef SCAN_ROW
    }
}

#ifndef SCAN_CHUNKED
#define SCAN_CHUNKED 2
#endif
typedef short sc_bf16x8 __attribute__((ext_vector_type(8)));
constexpr int SC_LDL = 72, SC_LDJ = 40;
__device__ __forceinline__ sc_bf16x8 sc_frag(const bf16* base, int ld, int row, int k0) { return *(const sc_bf16x8*)(base + row * ld + k0); }
__device__ __forceinline__ void ph_scan_chunk(const Ctx& C, int l) {
    bf16* At = (bf16*)C.lds; bf16* Bt = At + 16 * SC_LDL; bf16* Kt = Bt + 16 * SC_LDL; bf16* Rt = Kt + 16 * SC_LDL;
    bf16* BhT = Rt + 16 * SC_LDL; bf16* KhT = BhT + 64 * SC_LDJ; bf16* Vt = KhT + 64 * SC_LDJ; bf16* Pt = Vt + 64 * SC_LDJ; bf16* Ut = Pt + 64 * SC_LDJ;
    bf16* Mak = Ut + 64 * SC_LDJ; bf16* Nrb = Mak + 16 * SC_LDJ; bf16* Nrk = Nrb + 16 * SC_LDJ; bf16* Tb = Nrk + 16 * SC_LDJ;
    bf16* Sb = Tb + 16 * SC_LDJ;
    float* Mf = (float*)(Sb + 64 * SC_LDL); float* lw = Mf + 16 * 17; float* gc = lw + 16 * 64;
    const bf16* rkv = (const bf16*)(C.ws + WS_RKV); const _Float16* lr = (const _Float16*)(C.ws + WS_LR); bf16* ydir = (bf16*)(C.ws + WS_Y2);
    const int tid = opaque_tid(C.wave_s), lane = tid & 63, wv = __builtin_amdgcn_readfirstlane(tid >> 6), ss = tid >> 5, cp = tid & 31;
    const int fr = lane & 15, fq = lane >> 4;
    for (int it = blockIdx.x; it < 256; it += gridDim.x) {
        const int b = it >> 5, h = (it >> 1) & 15, dir = it & 1, ch = h * 64 + 2 * cp;
        const float kks0 = C.inp(I_KK)[l * BW + ch], kks1 = C.inp(I_KK)[l * BW + ch + 1], ka0 = C.inp(I_KA)[l * BW + ch], ka1 = C.inp(I_KA)[l * BW + ch + 1];
        const float dw0 = C.inp(I_DW0)[(l * 2 + dir) * BW + ch], dw1 = C.inp(I_DW0)[(l * 2 + dir) * BW + ch + 1], ia0 = C.inp(I_A0)[(l * 2 + dir) * BW + ch], ia1 = C.inp(I_A0)[(l * 2 + dir) * BW + ch + 1];
        for (int i = tid; i < (int)((char*)Mf - (char*)BhT) / 4; i += NTHR) ((unsigned*)BhT)[i] = 0u;
        f32x4 S0 = (f32x4){0.f, 0.f, 0.f, 0.f}, S1 = S0;
        unsigned rr, rk, rv; h2 rs, ra;
#define SCAN_ROW(g) ((g) < 256 ? (ML + b * 256 + (dir ? 255 - (g) : (g))) : (b * 4096 + (dir ? 4095 - ((g) - 256) : ((g) - 256))))
#define SCAN_LOAD(c) do { const size_t _row = (size_t)SCAN_ROW(16 * (c) + ss); rr = *(const unsigned*)(rkv + _row * 3072 + ch); rk = *(const unsigned*)(rkv + _row * 3072 + 1024 + ch); rv = *(const unsigned*)(rkv + _row * 3072 + 2048 + ch); \
        rs = *(const h2*)(lr + _row * NLR + dir * 1024 + ch); ra = *(const h2*)(lr + _row * NLR + 2048 + dir * 1024 + ch); } while (0)
        SCAN_LOAD(0);
        WG_BAR_LDS();
        for (int c = 0; c < 272; ++c) {
            const float k0 = bflo(rk), k1 = bfhi(rk), q0 = k0 * kks0, q1 = k1 * kks1; float sq = q0 * q0 + q1 * q1;
#pragma unroll
            for (int o = 1; o < 32; o <<= 1) sq += __shfl_xor(sq, o);
            const float inv = __builtin_amdgcn_rsqf(fmaxf(sq, 1e-24f)), n0 = q0 * inv, n1 = q1 * inv;
            const float a0 = fsigmoid((float)ra[0] + ia0), a1 = fsigmoid((float)ra[1] + ia1), sd0 = fsigmoid((float)rs[0] + dw0), sd1 = fsigmoid((float)rs[1] + dw1);
            const float kd0 = k0 * (1.f + (a0 - 1.f) * ka0), kd1 = k1 * (1.f + (a1 - 1.f) * ka1), r0 = bflo(rr), r1 = bfhi(rr), v0 = bflo(rv), v1 = bfhi(rv);
            *(f32x2v*)(lw + ss * 64 + 2 * cp) = (f32x2v){-0.60653065971f * sd0, -0.60653065971f * sd1};
            if (c + 1 < 272) SCAN_LOAD(c + 1);
            WG_BAR_LDS();
            if (tid < 64) { float run = 0.f;
                float t[16];
#pragma unroll
                for (int s2 = 0; s2 < 16; ++s2) t[s2] = lw[s2 * 64 + tid];
#pragma unroll
                for (int s2 = 0; s2 < 16; ++s2) { run += t[s2]; lw[s2 * 64 + tid] = run; } }
            WG_BAR_LDS();
            { const f32x2v cum = *(const f32x2v*)(lw + ss * 64 + 2 * cp), c15 = *(const f32x2v*)(lw + 15 * 64 + 2 * cp);
              f32x2v cpr = (f32x2v){0.f, 0.f}; if (ss > 0) cpr = *(const f32x2v*)(lw + (ss - 1) * 64 + 2 * cp);
              const float G0 = __expf(cum.x), G1 = __expf(cum.y), P0 = __expf(cpr.x), P1 = __expf(cpr.y), I0 = __expf(-cum.x), I1 = __expf(-cum.y), E0 = __expf(c15.x - cum.x), E1 = __expf(c15.y - cum.y);
              *(unsigned*)(At + ss * SC_LDL + 2 * cp) = pk2(-n0 * P0, -n1 * P1);
              *(unsigned*)(Bt + ss * SC_LDL + 2 * cp) = pk2(n0 * a0 * I0, n1 * a1 * I1);
              *(unsigned*)(Kt + ss * SC_LDL + 2 * cp) = pk2(kd0 * I0, kd1 * I1);
              *(unsigned*)(Rt + ss * SC_LDL + 2 * cp) = pk2(r0 * G0, r1 * G1);
              BhT[(2 * cp) * SC_LDJ + ss] = (bf16)f2bf(n0 * a0 * E0); BhT[(2 * cp + 1) * SC_LDJ + ss] = (bf16)f2bf(n1 * a1 * E1);
              KhT[(2 * cp) * SC_LDJ + ss] = (bf16)f2bf(kd0 * E0);      KhT[(2 * cp + 1) * SC_LDJ + ss] = (bf16)f2bf(kd1 * E1);
              Vt[(2 * cp) * SC_LDJ + ss] = (bf16)f2bf(v0);             Vt[(2 * cp + 1) * SC_LDJ + ss] = (bf16)f2bf(v1);
              if (ss == 15) *(f32x2v*)(gc + 2 * cp) = (f32x2v){__expf(c15.x), __expf(c15.y)}; }
            WG_BAR_LDS();
            f32x4 accP = (f32x4){0.f, 0.f, 0.f, 0.f}, accY = accP;
            if (wv < 4) { const bf16* X = (wv < 2) ? At : Rt; const bf16* Y = (wv & 1) ? Kt : Bt; f32x4 m = (f32x4){0.f, 0.f, 0.f, 0.f};
#pragma unroll
                for (int ks = 0; ks < 2; ++ks) m = __builtin_amdgcn_mfma_f32_16x16x32_bf16(sc_frag(X, SC_LDL, fr, 32 * ks + 8 * fq), sc_frag(Y, SC_LDL, fr, 32 * ks + 8 * fq), m, 0, 0, 0);
#pragma unroll
                for (int e = 0; e < 4; ++e) { const int i = 4 * fq + e; const bool keep = (wv < 2) ? (fr < i) : (fr <= i); const float val = keep ? m[e] : 0.f;
                    if (wv == 0) Mf[i * 17 + fr] = val; else ((wv == 1) ? Mak : (wv == 2) ? Nrb : Nrk)[i * SC_LDJ + fr] = (bf16)f2bf(val); }
            } else { const int tv = wv - 4;
#pragma unroll
                for (int ks = 0; ks < 2; ++ks) { const sc_bf16x8 sb = sc_frag(Sb, SC_LDL, 16 * tv + fr, 32 * ks + 8 * fq);
                    accP = __builtin_amdgcn_mfma_f32_16x16x32_bf16(sc_frag(At, SC_LDL, fr, 32 * ks + 8 * fq), sb, accP, 0, 0, 0);
                    accY = __builtin_amdgcn_mfma_f32_16x16x32_bf16(sc_frag(Rt, SC_LDL, fr, 32 * ks + 8 * fq), sb, accY, 0, 0, 0); } }
            WG_BAR_LDS();
            if (wv >= 4) { const int tv = wv - 4; const sc_bf16x8 vb = sc_frag(Vt, SC_LDJ, 16 * tv + fr, 8 * fq);
                accP = __builtin_amdgcn_mfma_f32_16x16x32_bf16(sc_frag(Mak, SC_LDJ, fr, 8 * fq), vb, accP, 0, 0, 0);
                accY = __builtin_amdgcn_mfma_f32_16x16x32_bf16(sc_frag(Nrk, SC_LDJ, fr, 8 * fq), vb, accY, 0, 0, 0);
                float* Pf = (float*)Pt + tv * (16 * 17);
#pragma unroll
                for (int e = 0; e < 4; ++e) Pf[fr * 17 + 4 * fq + e] = accP[e];
                float mrow[16];
#pragma unroll
                for (int i = 0; i < 16; ++i) mrow[i] = Mf[i * 17 + fr];
                LDS_WAIT();
                float u[16];
#pragma unroll
                for (int i = 0; i < 16; ++i) { float acc = Pf[fr * 17 + i];
#pragma unroll
                    for (int jj = 0; jj < i; ++jj) acc += __builtin_bit_cast(float, __builtin_amdgcn_readlane(__builtin_bit_cast(int, mrow[i]), jj)) * u[jj];
                    u[i] = acc; }
                if (fq == 0) {
#pragma unroll
                    for (int i = 0; i < 16; i += 2) *(unsigned*)(Ut + (16 * tv + fr) * SC_LDJ + i) = pk2(u[i], u[i + 1]); }
                LDS_WAIT();
                accY = __builtin_amdgcn_mfma_f32_16x16x32_bf16(sc_frag(Nrb, SC_LDJ, fr, 8 * fq), sc_frag(Ut, SC_LDJ, 16 * tv + fr, 8 * fq), accY, 0, 0, 0);
#pragma unroll
                for (int e = 0; e < 4; ++e) { const size_t row = (size_t)SCAN_ROW(16 * c + 4 * fq + e);
                    ydir[((size_t)dir * MT + row) * BW + h * 64 + 16 * tv + fr] = (bf16)f2bf(accY[e]); } }
            WG_BAR_LDS();
            { const int tv = wv >> 1, tk = 2 * (wv & 1);
              const sc_bf16x8 ua = sc_frag(Ut, SC_LDJ, 16 * tv + fr, 8 * fq), va = sc_frag(Vt, SC_LDJ, 16 * tv + fr, 8 * fq);
              const float g0 = gc[16 * tk + fr], g1 = gc[16 * (tk + 1) + fr];
              S0 = S0 * g0; S1 = S1 * g1;
              S0 = __builtin_amdgcn_mfma_f32_16x16x32_bf16(ua, sc_frag(BhT, SC_LDJ, 16 * tk + fr, 8 * fq), S0, 0, 0, 0);
              S0 = __builtin_amdgcn_mfma_f32_16x16x32_bf16(va, sc_frag(KhT, SC_LDJ, 16 * tk + fr, 8 * fq), S0, 0, 0, 0);
              S1 = __builtin_amdgcn_mfma_f32_16x16x32_bf16(ua, sc_frag(BhT, SC_LDJ, 16 * (tk + 1) + fr, 8 * fq), S1, 0, 0, 0);
              S1 = __builtin_amdgcn_mfma_f32_16x16x32_bf16(va, sc_frag(KhT, SC_LDJ, 16 * (tk + 1) + fr, 8 * fq), S1, 0, 0, 0);
#pragma unroll
              for (int e = 0; e < 4; ++e) { Sb[(16 * tv + 4 * fq + e) * SC_LDL + 16 * tk + fr] = (bf16)f2bf(S0[e]); Sb[(16 * tv + 4 * fq + e) * SC_LDL + 16 * (tk + 1) + fr] = (bf16)f2bf(S1[e]); } }
            WG_BAR_LDS();
        }
#undef SCAN_LOAD
#undef SCAN_ROW
    }
}

typedef _Float16 h4 __attribute__((ext_vector_type(4)));
struct __attribute__((aligned(8))) u32x2 { unsigned x, y; };
#define DPP_F(x, ctrl) __builtin_bit_cast(float, __builtin_amdgcn_update_dpp(0, __builtin_bit_cast(int, (x)), (ctrl), 0xF, 0xF, true))
constexpr int WSO_BYTES = 4 * 16 * SC_LDL * 2 + 3 * 64 * SC_LDJ * 2 + 256;
constexpr int WSX_BYTES = 16 * 17 * 4 + 3 * 16 * SC_LDJ * 2;
constexpr int WSC_BYTES = 16 * SC_LDL * 2 + 16 * 20 * 4 + 16 * SC_LDJ * 2;
constexpr int WS_SCAN_LDS = 3 * WSO_BYTES + 2 * WSX_BYTES + 4 * WSC_BYTES;
static_assert(WS_SCAN_LDS + 256 <= RING_BYTES && WSO_BYTES % 16 == 0 && WSX_BYTES % 16 == 0 && WSC_BYTES % 16 == 0, "scan LDS carve");
__device__ __forceinline__ void ph_scan_ws(const Ctx& C, int l) {
    unsigned char* const L = C.lds; float* const kkt = (float*)(L + WS_SCAN_LDS);
    const bf16* rkv = (const bf16*)(C.ws + WS_RKV); const _Float16* lr = (const _Float16*)(C.ws + WS_LR); bf16* ydir = (bf16*)(C.ws + WS_Y2);
    const int tid = opaque_tid(C.wave_s), lane = tid & 63, wv = __builtin_amdgcn_readfirstlane(tid >> 6);
    const int fr = lane & 15, fq = lane >> 4;
    for (int it = blockIdx.x; it < 256; it += gridDim.x) {
        const int b = it >> 5, h = (it >> 1) & 15, dir = it & 1;
        for (int i = tid; i < WS_SCAN_LDS / 4; i += NTHR) ((unsigned*)L)[i] = 0u;
        if (tid < 64) kkt[tid] = C.inp(I_KK)[l * BW + h * 64 + tid];
        WG_BAR_LDS();
#define SCAN_ROW(g) ((g) < 256 ? (ML + b * 256 + (dir ? 255 - (g) : (g))) : (b * 4096 + (dir ? 4095 - ((g) - 256) : ((g) - 256))))
        if (wv < 4) {
            const int cl = 16 * wv + 4 * fq, c0 = h * 64 + cl;
            float kko[4], kav[4], dwv[4], iav[4], kkn[16];
#pragma unroll
            for (int j = 0; j < 4; ++j) { kko[j] = kkt[cl + j]; kav[j] = C.inp(I_KA)[l * BW + c0 + j]; dwv[j] = C.inp(I_DW0)[(l * 2 + dir) * BW + c0 + j]; iav[j] = C.inp(I_A0)[(l * 2 + dir) * BW + c0 + j]; }
#pragma unroll
            for (int j = 0; j < 16; ++j) kkn[j] = kkt[16 * fq + j];
            struct Raw { u32x2 rr, rk, rv; h4 rs, ra; v4u kn0, kn1; } RA, RB;
#define WS_LOAD(R, c) do { const size_t _row = (size_t)SCAN_ROW(16 * (c) + fr); const bf16* _p = rkv + _row * 3072 + c0; R.rr = *(const u32x2*)_p; R.rk = *(const u32x2*)(_p + 1024); R.rv = *(const u32x2*)(_p + 2048); \
            R.rs = *(const h4*)(lr + _row * NLR + dir * 1024 + c0); R.ra = *(const h4*)(lr + _row * NLR + 2048 + dir * 1024 + c0); \
            R.kn0 = *(const v4u*)(rkv + _row * 3072 + 1024 + h * 64 + 16 * fq); R.kn1 = *(const v4u*)(rkv + _row * 3072 + 1024 + h * 64 + 16 * fq + 8); } while (0)
            WS_LOAD(RA, 0); WS_LOAD(RB, 1);
            __builtin_amdgcn_s_setprio(2);
            auto stage = [&](const int t, Raw& R, const int Q3) __attribute__((always_inline)) {
                {
                    unsigned char* O = L + Q3 * WSO_BYTES;
                    bf16* At = (bf16*)O; bf16* Bt = At + 16 * SC_LDL; bf16* Kt = Bt + 16 * SC_LDL; bf16* Rt = Kt + 16 * SC_LDL;
                    bf16* BhT = Rt + 16 * SC_LDL; bf16* KhT = BhT + 64 * SC_LDJ; bf16* Vt = KhT + 64 * SC_LDJ; float* gc = (float*)(Vt + 64 * SC_LDJ);
                    const float kf[4] = {bflo(R.rk.x), bfhi(R.rk.x), bflo(R.rk.y), bfhi(R.rk.y)}, rf[4] = {bflo(R.rr.x), bfhi(R.rr.x), bflo(R.rr.y), bfhi(R.rr.y)};
                    const unsigned vb0 = R.rv.x, vb1 = R.rv.y;
                    const unsigned knu[8] = {R.kn0.x, R.kn0.y, R.kn0.z, R.kn0.w, R.kn1.x, R.kn1.y, R.kn1.z, R.kn1.w};
                    f32x2v sq2 = (f32x2v){0.f, 0.f};
#pragma unroll
                    for (int j = 0; j < 8; ++j) { const f32x2v x = (f32x2v){bflo(knu[j]), bfhi(knu[j])} * (f32x2v){kkn[2 * j], kkn[2 * j + 1]}; sq2 += x * x; }
                    float sq = sq2.x + sq2.y;
                    sq += __shfl_xor(sq, 16); sq += __shfl_xor(sq, 32);
                    const float inv = __builtin_amdgcn_rsqf(fmaxf(sq, 1e-24f));
                    float nn[4], aa[4], kd[4], lwv[4];
#pragma unroll
                    for (int j = 0; j < 4; ++j) { nn[j] = kf[j] * kko[j] * inv; aa[j] = fsigmoid((float)R.ra[j] + iav[j]); const float sd = fsigmoid((float)R.rs[j] + dwv[j]);
                        kd[j] = kf[j] * (1.f + (aa[j] - 1.f) * kav[j]); lwv[j] = -0.60653065971f * sd; }
                    { const int tn = (t + 2 < 272) ? t + 2 : 271; WS_LOAD(R, tn); }
                    float at[4], bt[4], kt[4], rt[4], bh[4], kh[4], gt[4];
#pragma unroll
                    for (int j = 0; j < 4; ++j) {
                        float cum = lwv[j]; cum += DPP_F(cum, 0x111); cum += DPP_F(cum, 0x112); cum += DPP_F(cum, 0x114); cum += DPP_F(cum, 0x118);
                        const float tot = __builtin_bit_cast(float, __builtin_amdgcn_ds_swizzle(__builtin_bit_cast(int, cum), 0x1F0));
                        const float G = __expf(cum), GT = __expf(tot), I = __builtin_amdgcn_rcpf(G), E = GT * I;
                        const float P = __builtin_bit_cast(float, __builtin_amdgcn_update_dpp(0x3f800000, __builtin_bit_cast(int, G), 0x111, 0xF, 0xF, false));
                        const float na = nn[j] * aa[j];
                        at[j] = -nn[j] * P; bt[j] = na * I; kt[j] = kd[j] * I; rt[j] = rf[j] * G; bh[j] = na * E; kh[j] = kd[j] * E; gt[j] = GT; }
                    *(u32x2*)(At + fr * SC_LDL + cl) = (u32x2){pg8::cvt_pk_bf16(at[0], at[1]), pg8::cvt_pk_bf16(at[2], at[3])};
                    *(u32x2*)(Bt + fr * SC_LDL + cl) = (u32x2){pg8::cvt_pk_bf16(bt[0], bt[1]), pg8::cvt_pk_bf16(bt[2], bt[3])};
                    *(u32x2*)(Kt + fr * SC_LDL + cl) = (u32x2){pg8::cvt_pk_bf16(kt[0], kt[1]), pg8::cvt_pk_bf16(kt[2], kt[3])};
                    *(u32x2*)(Rt + fr * SC_LDL + cl) = (u32x2){pg8::cvt_pk_bf16(rt[0], rt[1]), pg8::cvt_pk_bf16(rt[2], rt[3])};
#pragma unroll
                    for (int j = 0; j < 4; j += 2) { const unsigned pb = pg8::cvt_pk_bf16(bh[j], bh[j + 1]), pk = pg8::cvt_pk_bf16(kh[j], kh[j + 1]);
                        BhT[(cl + j) * SC_LDJ + fr] = (bf16)(pb & 0xffffu); BhT[(cl + j + 1) * SC_LDJ + fr] = (bf16)(pb >> 16);
                        KhT[(cl + j) * SC_LDJ + fr] = (bf16)(pk & 0xffffu); KhT[(cl + j + 1) * SC_LDJ + fr] = (bf16)(pk >> 16); }
                    Vt[(cl + 0) * SC_LDJ + fr] = (bf16)(vb0 & 0xffffu); Vt[(cl + 1) * SC_LDJ + fr] = (bf16)(vb0 >> 16);
                    Vt[(cl + 2) * SC_LDJ + fr] = (bf16)(vb1 & 0xffffu); Vt[(cl + 3) * SC_LDJ + fr] = (bf16)(vb1 >> 16);
                    if (fr == 15) *(f32x4*)(gc + cl) = (f32x4){gt[0], gt[1], gt[2], gt[3]};
                }
            };
            auto mats = [&](const int Q3P, const int PAR) __attribute__((always_inline)) {
                {
                    unsigned char* O = L + Q3P * WSO_BYTES; unsigned char* X = L + 3 * WSO_BYTES + PAR * WSX_BYTES;
                    const bf16* At = (const bf16*)O; const bf16* Bt = At + 16 * SC_LDL; const bf16* Kt = Bt + 16 * SC_LDL; const bf16* Rt = Kt + 16 * SC_LDL;
                    float* Mf = (float*)X; bf16* Mak = (bf16*)(X + 16 * 17 * 4); bf16* Nrb = Mak + 16 * SC_LDJ; bf16* Nrk = Nrb + 16 * SC_LDJ;
                    const bf16* Xo = (wv < 2) ? At : Rt; const bf16* Yo = (wv & 1) ? Kt : Bt; f32x4 m = (f32x4){0.f, 0.f, 0.f, 0.f};
#pragma unroll
                    for (int ks = 0; ks < 2; ++ks) m = __builtin_amdgcn_mfma_f32_16x16x32_bf16(sc_frag(Xo, SC_LDL, fr, 32 * ks + 8 * fq), sc_frag(Yo, SC_LDL, fr, 32 * ks + 8 * fq), m, 0, 0, 0);
#pragma unroll
                    for (int e = 0; e < 4; ++e) { const int i = 4 * fq + e; const bool keep = (wv < 2) ? (fr < i) : (fr <= i); m[e] = keep ? m[e] : 0.f; }
                    if (wv == 0) {
                        *(f32x2v*)(Mf + ((2 * fq) * 16 + fr) * 2) = (f32x2v){m[0], m[1]}; *(f32x2v*)(Mf + ((2 * fq + 1) * 16 + fr) * 2) = (f32x2v){m[2], m[3]};
                    } else { bf16* Mo = (wv == 1) ? Mak : (wv == 2) ? Nrb : Nrk; const unsigned p01 = pg8::cvt_pk_bf16(m[0], m[1]), p23 = pg8::cvt_pk_bf16(m[2], m[3]);
                        Mo[(4 * fq + 0) * SC_LDJ + fr] = (bf16)(p01 & 0xffffu); Mo[(4 * fq + 1) * SC_LDJ + fr] = (bf16)(p01 >> 16);
                        Mo[(4 * fq + 2) * SC_LDJ + fr] = (bf16)(p23 & 0xffffu); Mo[(4 * fq + 3) * SC_LDJ + fr] = (bf16)(p23 >> 16); }
                }
            };
            stage(0, RA, 0); WG_BAR_LDS();
            stage(1, RB, 1); mats(0, 0); WG_BAR_LDS();
            for (int tb = 2; tb < 272; tb += 6) {
#pragma unroll
                for (int k = 0; k < 6; ++k) { if (k & 1) stage(tb + k, RB, (2 + k) % 3); else stage(tb + k, RA, (2 + k) % 3);
                    mats((1 + k) % 3, (1 + k) & 1); WG_BAR_LDS(); } }
            mats(271 % 3, 271 & 1); WG_BAR_LDS();
            WG_BAR_LDS();
            __builtin_amdgcn_s_setprio(0);
#undef WS_LOAD
        } else {
            const int tv = wv - 4;
            unsigned char* Pv = L + 3 * WSO_BYTES + 2 * WSX_BYTES + tv * WSC_BYTES;
            bf16* Sbw = (bf16*)Pv; float* Pfw = (float*)(Pv + 16 * SC_LDL * 2); bf16* Utw = (bf16*)(Pv + 16 * SC_LDL * 2 + 16 * 20 * 4);
            f32x4 S[4];
#pragma unroll
            for (int tk = 0; tk < 4; ++tk) S[tk] = (f32x4){0.f, 0.f, 0.f, 0.f};
            __builtin_amdgcn_s_waitcnt(0x0F70);
            auto cons = [&](const int t, const int Q3, const int PAR) __attribute__((always_inline)) {
                { const int c = t - 2;
                    unsigned char* O = L + Q3 * WSO_BYTES; unsigned char* X = L + 3 * WSO_BYTES + PAR * WSX_BYTES;
                    const bf16* At = (const bf16*)O; const bf16* Rt = At + 3 * 16 * SC_LDL;
                    const bf16* BhT = Rt + 16 * SC_LDL; const bf16* KhT = BhT + 64 * SC_LDJ; const bf16* Vt = KhT + 64 * SC_LDJ; const float* gc = (const float*)(Vt + 64 * SC_LDJ);
                    const float* Mf = (const float*)X; const bf16* Mak = (const bf16*)(X + 16 * 17 * 4); const bf16* Nrb = Mak + 16 * SC_LDJ; const bf16* Nrk = Nrb + 16 * SC_LDJ;
                    const sc_bf16x8 sb0 = sc_frag(Sbw, SC_LDL, fr, 8 * fq), sb1 = sc_frag(Sbw, SC_LDL, fr, 32 + 8 * fq);
                    const sc_bf16x8 at0 = sc_frag(At, SC_LDL, fr, 8 * fq), at1 = sc_frag(At, SC_LDL, fr, 32 + 8 * fq), rt0 = sc_frag(Rt, SC_LDL, fr, 8 * fq), rt1 = sc_frag(Rt, SC_LDL, fr, 32 + 8 * fq);
                    const sc_bf16x8 vb = sc_frag(Vt, SC_LDJ, 16 * tv + fr, 8 * fq), mak = sc_frag(Mak, SC_LDJ, fr, 8 * fq), nrk = sc_frag(Nrk, SC_LDJ, fr, 8 * fq), nrb = sc_frag(Nrb, SC_LDJ, fr, 8 * fq);
                    f32x4 mm[28]; f32x2v md[8];
#pragma unroll
                    for (int ip = 0; ip < 5; ++ip) {
#pragma unroll
                        for (int jj = 0; jj < ip; ++jj) mm[ip * (ip - 1) / 2 + jj] = *(const f32x4*)(Mf + (ip * 16 + 2 * jj) * 2);
                        md[ip] = *(const f32x2v*)(Mf + (ip * 16 + 2 * ip) * 2); }
                    __builtin_amdgcn_sched_barrier(0);
                    const f32x4 z4 = (f32x4){0.f, 0.f, 0.f, 0.f};
                    f32x4 accP = __builtin_amdgcn_mfma_f32_16x16x32_bf16(at0, sb0, z4, 0, 0, 0), accY = __builtin_amdgcn_mfma_f32_16x16x32_bf16(rt0, sb0, z4, 0, 0, 0);
                    accP = __builtin_amdgcn_mfma_f32_16x16x32_bf16(at1, sb1, accP, 0, 0, 0); accY = __builtin_amdgcn_mfma_f32_16x16x32_bf16(rt1, sb1, accY, 0, 0, 0);
                    accP = __builtin_amdgcn_mfma_f32_16x16x32_bf16(mak, vb, accP, 0, 0, 0);  accY = __builtin_amdgcn_mfma_f32_16x16x32_bf16(nrk, vb, accY, 0, 0, 0);
#pragma unroll
                    for (int ip = 5; ip < 8; ++ip) {
#pragma unroll
                        for (int jj = 0; jj < ip; ++jj) mm[ip * (ip - 1) / 2 + jj] = *(const f32x4*)(Mf + (ip * 16 + 2 * jj) * 2);
                        md[ip] = *(const f32x2v*)(Mf + (ip * 16 + 2 * ip) * 2); }
                    __builtin_amdgcn_sched_barrier(0);
                    *(f32x4*)(Pfw + fr * 20 + 4 * fq) = accP;
                    f32x4 pq[4];
#pragma unroll
                    for (int q = 0; q < 4; ++q) pq[q] = *(const f32x4*)(Pfw + fr * 20 + 4 * q);
                    float u[16];
#define WS_SUBST(ip) do { f32x2v acc = (f32x2v){pq[(ip) >> 1][2 * ((ip) & 1)], pq[(ip) >> 1][2 * ((ip) & 1) + 1]};   \
                        _Pragma("unroll") for (int jj = 0; jj < (ip); ++jj) { const f32x4 m4 = mm[(ip) * ((ip) - 1) / 2 + jj]; \
                            acc += (f32x2v){m4.x, m4.y} * (f32x2v){u[2 * jj], u[2 * jj]}; acc += (f32x2v){m4.z, m4.w} * (f32x2v){u[2 * jj + 1], u[2 * jj + 1]}; } \
                        u[2 * (ip)] = acc.x; u[2 * (ip) + 1] = acc.y + md[ip].y * acc.x; } while (0)
                    WS_SUBST(0); WS_SUBST(1); WS_SUBST(2); WS_SUBST(3); WS_SUBST(4);
                    sc_bf16x8 bh[4], kh[4]; float gcv[4];
#pragma unroll
                    for (int tk = 0; tk < 4; ++tk) { bh[tk] = sc_frag(BhT, SC_LDJ, 16 * tk + fr, 8 * fq); kh[tk] = sc_frag(KhT, SC_LDJ, 16 * tk + fr, 8 * fq); gcv[tk] = gc[16 * tk + fr]; }
                    __builtin_amdgcn_sched_barrier(0);
                    WS_SUBST(5); WS_SUBST(6); WS_SUBST(7);
#undef WS_SUBST
                    v4u uw;
#pragma unroll
                    for (int q = 0; q < 4; ++q) { const unsigned lo = pg8::cvt_pk_bf16(u[2 * q], u[2 * q + 1]), hi = pg8::cvt_pk_bf16(u[8 + 2 * q], u[8 + 2 * q + 1]); uw[q] = (fq == 0) ? lo : (fq == 1) ? hi : 0u; }
                    const sc_bf16x8 ua = __builtin_bit_cast(sc_bf16x8, uw);
                    accY = __builtin_amdgcn_mfma_f32_16x16x32_bf16(nrb, ua, accY, 0, 0, 0);
#pragma unroll
                    for (int e = 0; e < 4; e += 2) { const unsigned py = pg8::cvt_pk_bf16(accY[e], accY[e + 1]);
                        ydir[((size_t)dir * MT + (size_t)SCAN_ROW(16 * c + 4 * fq + e)) * BW + h * 64 + 16 * tv + fr] = (bf16)(py & 0xffffu);
                        ydir[((size_t)dir * MT + (size_t)SCAN_ROW(16 * c + 4 * fq + e + 1)) * BW + h * 64 + 16 * tv + fr] = (bf16)(py >> 16); }
#pragma unroll
                    for (int tk = 0; tk < 4; ++tk) {
                        S[tk] = S[tk] * gcv[tk];
                        S[tk] = __builtin_amdgcn_mfma_f32_16x16x32_bf16(ua, bh[tk], S[tk], 0, 0, 0);
                        S[tk] = __builtin_amdgcn_mfma_f32_16x16x32_bf16(vb, kh[tk], S[tk], 0, 0, 0); }
#pragma unroll
                    for (int tk = 0; tk < 4; ++tk) {
#pragma unroll
                        for (int e = 0; e < 4; e += 2) { const unsigned ps = pg8::cvt_pk_bf16(S[tk][e], S[tk][e + 1]);
                            Sbw[(4 * fq + e) * SC_LDL + 16 * tk + fr] = (bf16)(ps & 0xffffu); Sbw[(4 * fq + e + 1) * SC_LDL + 16 * tk + fr] = (bf16)(ps >> 16); } }
                }
            };
            WG_BAR_LDS(); WG_BAR_LDS();
            { int q3 = 0;
#pragma nounroll
              for (int t = 2; t < 274; ++t) { cons(t, q3, t & 1); q3 = (q3 == 2) ? 0 : q3 + 1; WG_BAR_LDS(); } }
        }
#undef SCAN_ROW
    }
}

__device__ __forceinline__ void ph_rwkvout(const Ctx& C, int l, int Mrows) {
    const int tid = opaque_tid(C.wave_s), lane = tid & 63, wave = __builtin_amdgcn_readfirstlane(tid >> 6), cG = opaque_s(C.G), cvcu = opaque_s(C.vcu); (void)lane; (void)wave; (void)cG; (void)cvcu;

    const int bidx = opaque_s((int)blockIdx.x), nwg2 = (MT / 256) * (N2 / 256), nl = nwg2 - (nwg2 / cG) * cG, RW_D = (nl > 0 && nl < cG) ? 47 : 0;
    const int xr = (Mrows - (cG - nl) * RW_D) / cG, extra = Mrows - (nl * xr + (cG - nl) * (xr + RW_D));
    const int mlo = (bidx < nl ? bidx * xr : nl * xr + (bidx - nl) * (xr + RW_D)) + (bidx < extra ? bidx : extra);
    const int mhi = mlo + (bidx < nl ? xr : xr + RW_D) + (bidx < extra ? 1 : 0);
    const bf16* rkv = (const bf16*)(C.ws + WS_RKV); const _Float16* lr = (const _Float16*)(C.ws + WS_LR); const bf16* ydir = (const bf16*)(C.ws + WS_Y2); bf16* ya = (bf16*)(C.ws + WS_YA);
    for (int m = mlo + wave; m < mhi; m += NWAVES) {
#pragma unroll
        for (int hp = 0; hp < 8; ++hp) { const int col = hp * 128 + 2 * lane;
            const unsigned wr = *(const unsigned*)(rkv + (size_t)m * 3072 + col), wk = *(const unsigned*)(rkv + (size_t)m * 3072 + 1024 + col), wvv = *(const unsigned*)(rkv + (size_t)m * 3072 + 2048 + col);
            const unsigned yf = *(const unsigned*)(ydir + (size_t)m * BW + col), ybk = *(const unsigned*)(ydir + ((size_t)MT + m) * BW + col);
            const h2 p0 = *(const h2*)(lr + (size_t)m * NLR + 2048 + col), p1 = *(const h2*)(lr + (size_t)m * NLR + 3072 + col), gg = *(const h2*)(lr + (size_t)m * NLR + 4096 + col);
            const f32x2v b0 = *(const f32x2v*)(C.inp(I_A0) + (l * 2 + 0) * BW + col), b1 = *(const f32x2v*)(C.inp(I_A0) + (l * 2 + 1) * BW + col);
            const f32x2v a0 = (f32x2v){fsigmoid((float)p0[0] + b0.x), fsigmoid((float)p0[1] + b0.y)}, a1 = (f32x2v){fsigmoid((float)p1[0] + b1.x), fsigmoid((float)p1[1] + b1.y)};
            const f32x2v ka = *(const f32x2v*)(C.inp(I_KA) + l * BW + col), rk = *(const f32x2v*)(C.inp(I_RK) + l * BW + col), lw = *(const f32x2v*)(C.inp(I_LNW) + l * BW + col), lb = *(const f32x2v*)(C.inp(I_LNB) + l * BW + col);
            const float y0 = bflo(yf) + bflo(ybk), y1 = bfhi(yf) + bfhi(ybk);
            float s1 = y0 + y1;
            float bon = bflo(wr) * rk.x * bflo(wk) * (2.f + (a0.x + a1.x - 2.f) * ka.x) + bfhi(wr) * rk.y * bfhi(wk) * (2.f + (a0.y + a1.y - 2.f) * ka.y);
#pragma unroll
            for (int o = 1; o < 32; o <<= 1) { s1 += __shfl_xor(s1, o); bon += __shfl_xor(bon, o); }
            const float mu = s1 * (1.f / 64.f), e0 = y0 - mu, e1 = y1 - mu; float s2 = e0 * e0 + e1 * e1;
#pragma unroll
            for (int o = 1; o < 32; o <<= 1) s2 += __shfl_xor(s2, o);
            const float rstd = rsqrtf(s2 * (1.f / 64.f) + 64e-5f);
            const float o0 = ((e0 * rstd) * lw.x + lb.x + bon * bflo(wvv)) * (float)gg[0], o1 = ((e1 * rstd) * lw.y + lb.y + bon * bfhi(wvv)) * (float)gg[1];
            *(unsigned*)(ya + (size_t)m * BW + col) = pk2(o0, o1); }
    }
}

__device__ __forceinline__ void ph_attn(const Ctx& C, int l, bool ctx_out) {
    const att::bf16* Z2 = (const att::bf16*)(C.ws + WS_Z); att::bf16* yc = (att::bf16*)(C.ws + WS_YC);
    float* tmp = (float*)(C.ws + WS_ATMP) + (size_t)blockIdx.x * 256 * 128;
    const float lam = ((const float*)(C.ws + WS_MISC))[2048 + l];
    const float lam_init = 0.8f - 0.6f * expf(-0.3f * (float)l);
    const float* subg = C.inp(I_SUBG) + l * 128;
    const int cG = opaque_s(C.G), cvcu = opaque_s(C.vcu);
    for (int i = 0;; ++i) {
        const int u = i * cG + cvcu;
        int qrow0, klat0, kctx0, nlat, NT, h;
        if (u < 1024) { const int b = u >> 7; h = (u >> 4) & 7; const int qb = u & 15; qrow0 = b * SEQ + qb * 256; klat0 = b * SEQ; kctx0 = ML + b * CTXL; nlat = 64; NT = 68; }
        else if (ctx_out && u < 1024 + 64) { const int uc = u - 1024, b = uc >> 3; h = uc & 7; qrow0 = ML + b * CTXL; klat0 = 0; kctx0 = ML + b * CTXL; nlat = 0; NT = 4; }
        else break;
        att::body<0>(Z2, qrow0, klat0, kctx0, nlat, NT, h * 128, 1024 + h * 128, 2048 + h * 128, tmp, nullptr, 0.f, subg, 0.f, (char*)C.lds, C.wave_s);
        att::body<1>(Z2, qrow0, klat0, kctx0, nlat, NT, h * 128 + 64, 1024 + h * 128 + 64, 2048 + h * 128, tmp, yc + (size_t)qrow0 * BW + h * 128, lam, subg, 1.f - lam_init, (char*)C.lds, C.wave_s);
    }
    __syncthreads();
}

constexpr int PH_PER_LAYER = 12, N_PHASES = 1 + DEPTH * PH_PER_LAYER + 1;
struct Args { const float* in[N_IN]; float* out; unsigned char* ws; int ph_lo, ph_hi, bar_region, pad; };
template <unsigned KMASK> __device__ __forceinline__ void mk_body(const Args& args) {
    extern __shared__ __attribute__((aligned(16))) unsigned char lds[];
    Ctx C;
    C.lds = lds; C.wave_s = __builtin_amdgcn_readfirstlane((int)threadIdx.x >> 6);
    C.G = gridDim.x; { const int bx = blockIdx.x; C.vcu = (C.G % 8 == 0) ? (bx % 8) * (C.G / 8) + bx / 8 : bx; }
    C.ka = (const float* const __attribute__((address_space(4)))*)__builtin_amdgcn_kernarg_segment_ptr();
    C.out = args.out; C.ws = args.ws;
    LAS unsigned char* ldsl = (LAS unsigned char*)lds;
    for (int u = opaque_tid(C.wave_s); u < (LDS_BYTES - LDSCTL_OFF) / 4; u += NTHR) ((LAS unsigned*)(ldsl + LDSCTL_OFF))[u] = 0u;
    __syncthreads();
    const int lo = args.ph_lo, hi = args.ph_hi;
    const bool multi = (hi - lo) > 1;
    XcdBarrier bar; bar.bar = (unsigned*)(C.ws + WS_CTL) + CW_BAR + args.bar_region * XCD_BAR_WORDS; bar.x = 0; bar.st = nullptr;
    if (multi) bar = xcd_barrier_post((unsigned*)(C.ws + WS_CTL) + CW_BAR + args.bar_region * XCD_BAR_WORDS, (volatile LAS unsigned*)(ldsl + MISC_OFF) + 8, opaque_tid(C.wave_s) == 0);
#define IN(k) (lo <= (k) && (k) < hi)
#define EN(b) ((KMASK >> (b)) & 1u)
#define SEAM(k) do { if (IN((k) + 1)) xcd_barrier(bar, opaque_tid(C.wave_s) == 0); } while (0)
    using namespace pg8;
    bf16_t* const H = (bf16_t*)(C.ws + WS_H); bf16_t* const Z = (bf16_t*)(C.ws + WS_Z);
    float* const mods_all = (float*)(C.ws + WS_MODS);

    if (EN(0) && IN(0)) { ph_mods(C); SEAM(0); }
    for (int l = 0; l < DEPTH; ++l) {
        const int p0 = 1 + l * PH_PER_LAYER;
        if (hi <= p0 || lo >= p0 + PH_PER_LAYER) continue;
        const bool ctx_out = l < DEPTH - 1;
        const int Mx = ctx_out ? MT : ML;
        const float* mods_l = mods_all + (size_t)l * 9 * NMODC;
#define G opaque_s(C.G)
#define bid opaque_s((int)blockIdx.x)
        if (EN(1) && IN(p0 + 0)) { ph_wprep(C, l); ph_norm(C, l, 0, MT); SEAM(p0 + 0); }
        if (EN(2) && IN(p0 + 1)) { Gemm g{H, (const bf16_t*)(C.ws + WS_W1T), MT, N1, DM, DM}; StaticOrder S; S.init(MT, N1, G, bid, 4); EpiZ1 E{Z};
            gemm_phase<EpiZ1, StaticOrder, true, true>(ldsl, g, S, E, C.wave_s); SEAM(p0 + 1); }
        if (EN(3) && IN(p0 + 2)) { ph_convpool(C, l);
            Gemm g{Z + 3072, (const bf16_t*)(C.ws + WS_WLRT), MT, NLR, KLR, N1};
            StaticOrder S; S.init(MT, NLR, G, bid, 4);
            EpiLr E{(_Float16*)(C.ws + WS_LR)};
            gemm_phase<EpiLr, StaticOrder, true, true>(ldsl, g, S, E, C.wave_s); SEAM(p0 + 2); }
        if (EN(4) && IN(p0 + 3)) { if (SCAN_CHUNKED == 2) ph_scan_ws(C, l); else if (SCAN_CHUNKED) ph_scan_chunk(C, l); else ph_scan(C, l); SEAM(p0 + 3); }
        if (EN(5) && IN(p0 + 4)) { ph_rwkvout(C, l, Mx);
            Gemm g{H, (const bf16_t*)(C.ws + WS_W2T), MT, N2, DM, DM}; StaticOrder S; S.init(MT, N2, G, bid, 4); EpiZ2 E{Z, (const float*)(C.ws + WS_MISC), (const float*)(C.ws + WS_MISC) + 1024};
            gemm_phase<EpiZ2, StaticOrder, true, true>(ldsl, g, S, E, C.wave_s); SEAM(p0 + 4); }
        if (EN(6) && IN(p0 + 5)) { ph_attn(C, l, ctx_out); SEAM(p0 + 5); }
        if (EN(7) && IN(p0 + 6)) {
            Gemm g{H, (const bf16_t*)(C.ws + WS_W3T), Mx, N3, DM, DM};
            StaticOrder S; S.init(Mx, N3, G, bid, 4);
            EpiGate E{Z};
            gemm_phase<EpiGate, StaticOrder, true, true>(ldsl, g, S, E, C.wave_s);
            SEAM(p0 + 6); }
        if (EN(8) && IN(p0 + 7)) { bf16_t* accb = (bf16_t*)(C.ws + WS_RKV); const bf16_t* WB = (const bf16_t*)(C.ws + WS_WBT);
            StaticOrder S; S.init(Mx, DM, G, bid, 2);
            { Gemm g{(const bf16_t*)(C.ws + WS_YA), WB, Mx, DM, BW, BW}; EpiMerge<0> E{Z, accb}; gemm_phase<EpiMerge<0>, StaticOrder, true, true>(ldsl, g, S, E, C.wave_s); }
            { Gemm g{(const bf16_t*)(C.ws + WS_POOL), WB + (size_t)DM * BW, Mx, DM, BW, BW}; EpiMerge<1> E{Z, accb}; gemm_phase<EpiMerge<1>, StaticOrder, true, true>(ldsl, g, S, E, C.wave_s); }
            { Gemm g{(const bf16_t*)(C.ws + WS_YC), WB + (size_t)2 * DM * BW, Mx, DM, BW, BW}; EpiMerge<2> E{Z, accb}; gemm_phase<EpiMerge<2>, StaticOrder, true, true>(ldsl, g, S, E, C.wave_s); }
            SEAM(p0 + 7); }
        if (EN(9) && IN(p0 + 8)) { Gemm g{(const bf16_t*)(C.ws + WS_RKV), (const bf16_t*)(C.ws + WS_WOT), Mx, DM, DM, DM}; StaticOrder S; S.init(Mx, DM, G, bid, 2);
            EpiRes E{l == 0 ? C.inp(I_X) : C.out, C.out, l == 0 ? C.inp(I_CTX) : (const float*)(C.ws + WS_XC), (float*)(C.ws + WS_XC), mods_l + 2 * DM,
                     1.0f};
            gemm_phase<EpiRes, StaticOrder, true, true>(ldsl, g, S, E, C.wave_s); SEAM(p0 + 8); }
        if (EN(10) && IN(p0 + 9)) { ph_norm(C, l, 1, Mx); SEAM(p0 + 9); }
        if (EN(11) && IN(p0 + 10)) { Gemm g{H, (const bf16_t*)(C.ws + WS_WFIT), Mx, NFI, DM, DM}; StaticOrder S; S.init(Mx, NFI, G, bid, 4); EpiSwiglu E{Z};
            gemm_phase<EpiSwiglu, StaticOrder, true, true>(ldsl, g, S, E, C.wave_s); SEAM(p0 + 10); }
        if (EN(12) && IN(p0 + 11)) { Gemm g{Z, (const bf16_t*)(C.ws + WS_WFOT), Mx, DM, DFF, DFF}; StaticOrder S; S.init(Mx, DM, G, bid, 2);
            EpiRes E{C.out, C.out, (const float*)(C.ws + WS_XC), (float*)(C.ws + WS_XC), mods_l + 5 * DM, 1.0f};
            gemm_phase<EpiRes, StaticOrder, true, true>(ldsl, g, S, E, C.wave_s); SEAM(p0 + 11); }
    }
#undef G
#undef bid
    if (EN(13) && IN(N_PHASES - 1)) ph_final(C);
#undef IN
#undef SEAM
}


#ifndef PH_MASK
#define PH_MASK 0xFFFFu
#endif
template <unsigned KMASK> __global__ void __launch_bounds__(NTHR, 2) mk_k(Args args) {
    mk_body<KMASK>(args);
}
#if !MK_SPLIT
__global__ void __launch_bounds__(NTHR, 2) mk_fwd(Args args) { mk_body<PH_MASK>(args); }
#endif
static inline int kind_of(int p) { return p == 0 ? 0 : p == N_PHASES - 1 ? 13 : 1 + (p - 1) % PH_PER_LAYER; }
typedef void (*kern_t)(Args);
static kern_t kern_of(int kind) {
    switch (kind) { case 0: return mk_k<1u << 0>; case 1: return mk_k<1u << 1>; case 2: return mk_k<1u << 2>; case 3: return mk_k<1u << 3>; case 4: return mk_k<1u << 4>; case 5: return mk_k<1u << 5>; case 6: return mk_k<1u << 6>;
                    case 7: return mk_k<1u << 7>; case 8: return mk_k<1u << 8>; case 9: return mk_k<1u << 9>; case 10: return mk_k<1u << 10>; case 11: return mk_k<1u << 11>; case 12: return mk_k<1u << 12>; default: return mk_k<1u << 13>; }
}
extern "C" void kernel_launch(void* const* d_in, const int* in_sizes, int n_in, void* d_out, int out_size, void* d_ws, size_t ws_size, hipStream_t stream) {
    static int grid = 0;
    if (grid == 0) {
        if (n_in != N_IN || out_size != ML * DM || ws_size < WS_END) { fprintf(stderr, "kernel_launch: shape mismatch: n_in %d out %d ws %zu (need %zu)\n", n_in, out_size, ws_size, (size_t)WS_END); grid = -1; return; }
        int dev = 0, cus = 0, per_cu = 0;
        if (hipGetDevice(&dev) != hipSuccess || hipDeviceGetAttribute(&cus, hipDeviceAttributeMultiprocessorCount, dev) != hipSuccess) { grid = -1; return; }
#if MK_SPLIT
        for (int k = 0; k < 14; ++k) if (hipFuncSetAttribute((const void*)kern_of(k), hipFuncAttributeMaxDynamicSharedMemorySize, LDS_BYTES) != hipSuccess) { fprintf(stderr, "kernel_launch: hipFuncSetAttribute failed (kind %d)\n", k); grid = -1; return; }
        (void)per_cu;
#else
        if (hipFuncSetAttribute((const void*)mk_fwd, hipFuncAttributeMaxDynamicSharedMemorySize, LDS_BYTES) != hipSuccess) { fprintf(stderr, "kernel_launch: hipFuncSetAttribute failed\n"); grid = -1; return; }
        if (hipOccupancyMaxActiveBlocksPerMultiprocessor(&per_cu, (const void*)mk_fwd, NTHR, LDS_BYTES) != hipSuccess || per_cu < 1) fprintf(stderr, "kernel_launch: occupancy query says %d\n", per_cu);
#endif
        (void)hipGetLastError();
        grid = cus;
    }
    if (grid < 0) return;
    if (hipMemsetAsync((char*)d_ws + WS_CTL, 0, CTL_ZERO_BYTES, stream) != hipSuccess) { fprintf(stderr, "kernel_launch: memset failed\n"); return; }
    Args a{};
    for (int i = 0; i < N_IN; ++i) a.in[i] = (const float*)d_in[i];
    a.out = (float*)d_out; a.ws = (unsigned char*)d_ws; a.bar_region = 0; a.pad = 0;
#if MK_SPLIT
    for (int p = 0; p < N_PHASES; ++p) {
        a.ph_lo = p; a.ph_hi = p + 1;
        const int kind = kind_of(p);
        hipLaunchKernelGGL(kern_of(kind), dim3(grid), dim3(NTHR), LDS_BYTES, stream, a);
    }
#else
    a.ph_lo = 0; a.ph_hi = N_PHASES; hipLaunchKernelGGL(mk_fwd, dim3(grid), dim3(NTHR), LDS_BYTES, stream, a);
#endif
    const hipError_t le = hipPeekAtLastError();
    if (le != hipSuccess) fprintf(stderr, "kernel_launch: launch failed: %s\n", hipGetErrorName(le));
}
```

```cpp
#include <hip/hip_runtime.h>
#include <cstdio>
#include <cstdint>

__device__ __forceinline__ int lane_id_asm() { int l; asm volatile("v_mbcnt_lo_u32_b32 %0, -1, 0\n\tv_mbcnt_hi_u32_b32 %0, -1, %0" : "=v"(l)); return l; }

namespace pg8 {
#define PG8_LAS __attribute__((address_space(3)))
typedef unsigned short bf16_t;
typedef short bf16x8 __attribute__((ext_vector_type(8)));
typedef float f32x4 __attribute__((ext_vector_type(4)));
typedef unsigned u32x4 __attribute__((ext_vector_type(4)));
constexpr int BM = 256, BK = 64, HALF = 128, HTB = HALF * BK * 2  , STAGE_BYTES = 8 * HTB, NXCD = 8, WGM = 4;

__host__ __device__ __forceinline__ int lds_byte(int r, int c) { const int st = (r >> 4) * 2 + (c >> 5), rr = r & 15, cc = c & 31, ob = rr * 64 + cc * 2; return st * 1024 + (ob ^ (((ob >> 9) & 1) << 5)); }
__host__ __device__ __forceinline__ void stage_rc(int b, int& R, int& C) { const int st = b / 1024, sb = b % 1024, swz = sb ^ (((sb >> 9) & 1) << 5); R = (st >> 1) * 16 + swz / 64; C = (st & 1) * 32 + (swz % 64) / 2; }
__host__ __device__ __forceinline__ int perm32(int rho) { const int n = rho >> 4, i = rho & 15; return 8 * (i >> 2) + 4 * n + (i & 3); }

struct Unit { int pm, pn; };
struct Gemm { const bf16_t* A; const bf16_t* Bt; int M, N, K, lda; };

struct StaticOrder {
    int nM, nN, nwg, G, c, wgm;
    __host__ __device__ void init(int M, int N, int G_, int c_, int wgm_ = WGM) { nM = M / BM; nN = N / BM; nwg = nM * nN; G = G_; c = c_; wgm = wgm_; }
    __host__ __device__ bool next(int i, Unit& u) const {
        const long L = (long)i * G + c; if (L >= nwg) return false;
        int wgid = (int)L; { const int q = nwg / NXCD, r = nwg % NXCD, xcd = wgid % NXCD, off = wgid / NXCD; wgid = (xcd < r ? xcd * (q + 1) : r * (q + 1) + (xcd - r) * q) + off; }
        const int nig = wgm * nN, gid = wgid / nig, fm = gid * wgm, gsz = (nM - fm) < wgm ? (nM - fm) : wgm;
        u.pm = fm + ((wgid % nig) % gsz); u.pn = (wgid % nig) / gsz; return true;
    }
    __device__ __forceinline__ void a_ready(const Unit&) const {}
    __device__ __forceinline__ void done(const Unit&) const {}
};
typedef __bf16 bf16x2_t __attribute__((ext_vector_type(2)));
typedef float f32x2_t __attribute__((ext_vector_type(2)));
__device__ __forceinline__ unsigned cvt_pk_bf16(float lo, float hi) { const f32x2_t v = {lo, hi}; const bf16x2_t b = __builtin_convertvector(v, bf16x2_t); return __builtin_bit_cast(unsigned, b); }
typedef float f32x2 __attribute__((ext_vector_type(2)));

template <class Epi, class Sched, bool ALIGN_EPI = false, bool SP2 = false>
__device__ __forceinline__ void gemm_phase(PG8_LAS unsigned char* lds, const Gemm g, const Sched& S, const Epi& E, int wave_s) {
    int tid_ = (wave_s << 6) | lane_id_asm(); asm volatile("" : "+v"(tid_)); const int tid = tid_, wid = __builtin_amdgcn_readfirstlane(tid >> 6), lane = tid & 63, wr = wid >> 2, wc = wid & 3, fr = lane & 15, fq = lane >> 4;
    const int K = g.K, nt = K / BK;
    unsigned voffA[2], voffB[2];
#pragma unroll
    for (int i = 0; i < 2; ++i) { int R, C; stage_rc(tid * 16 + i * 8192, R, C); const int Rb = Epi::PERM ? ((R & ~31) + perm32(R & 31)) : R;
        voffA[i] = (unsigned)(R * g.lda + C) * 2u; voffB[i] = (unsigned)(Rb * K + C) * 2u; }
    const size_t kstep = (size_t)(BK * 2);
    const size_t hstepB = (size_t)HALF * K * 2, hstepA = (size_t)HALF * g.lda * 2;
    const size_t tstepA = 2 * hstepA, tstepB = 2 * hstepB;
    const unsigned ldsw = (unsigned)wid * 1024u;
    const int aoff = lds_byte(wr * 64 + fr, fq * 8), boff = lds_byte(wc * 32 + fr, fq * 8);
#define PG8_SA(b, h) (((b) * 2 + (h)) * HTB)
#define PG8_SB(b, h) ((4 + (b) * 2 + (h)) * HTB)
#define PG8_STAGE(bufoff, gbase, voff) do { _Pragma("unroll") for (int _i = 0; _i < 2; ++_i) \
        __builtin_amdgcn_global_load_lds((const unsigned*)((const char*)(gbase) + (voff)[_i]), (PG8_LAS unsigned*)(lds + (bufoff) + ldsw + _i * 8192), 16, 0, 0); } while (0)
#define PG8_LDA(dst, b, h) do { _Pragma("unroll") for (int m = 0; m < 4; ++m) _Pragma("unroll") for (int k = 0; k < 2; ++k) dst[m][k] = *(const PG8_LAS bf16x8*)(lds + PG8_SA(b, h) + aoff + m * 2048 + k * 1024); } while (0)
#define PG8_LDB(dst, b, h) do { _Pragma("unroll") for (int n = 0; n < 2; ++n) _Pragma("unroll") for (int k = 0; k < 2; ++k) dst[n][k] = *(const PG8_LAS bf16x8*)(lds + PG8_SB(b, h) + boff + n * 2048 + k * 1024); } while (0)
#define PG8_MMA(ai, bj, At, Bt) do { __builtin_amdgcn_s_setprio(1); _Pragma("unroll") for (int m = 0; m < 4; ++m) _Pragma("unroll") for (int n = 0; n < 2; ++n) _Pragma("unroll") for (int k = 0; k < 2; ++k) \
        acc[ai][bj][m][n] = __builtin_amdgcn_mfma_f32_16x16x32_bf16(Bt[n][k], At[m][k], acc[ai][bj][m][n], 0, 0, 0); __builtin_amdgcn_s_setprio(0); } while (0)
#define PG8_WAIT_V(n) asm volatile("s_waitcnt vmcnt(" #n ")" ::: "memory")
#define PG8_WAIT_L(n) asm volatile("s_waitcnt lgkmcnt(" #n ")" ::: "memory")
#define PG8_BAR __builtin_amdgcn_s_barrier()
#define PG8_SCHED __builtin_amdgcn_sched_barrier(0)
    Unit cur, nxt; int ui = 0;
    if (!S.next(0, cur)) return;
    f32x4 acc[2][2][4][2];
#pragma unroll
    for (int a = 0; a < 2; ++a)
#pragma unroll
        for (int b = 0; b < 2; ++b)
#pragma unroll
            for (int m = 0; m < 4; ++m)
#pragma unroll
                for (int n = 0; n < 2; ++n) acc[a][b][m][n] = (f32x4){0.f, 0.f, 0.f, 0.f};
    bf16x8 At[4][2], B0[2][2], B1[2][2];
    const char* cA = (const char*)g.A + (size_t)cur.pm * tstepA; const char* cB = (const char*)g.Bt + (size_t)cur.pn * tstepB;
    S.a_ready(cur);
    if constexpr (SP2) {
        PG8_STAGE(PG8_SB(0, 0), cB, voffB); PG8_STAGE(PG8_SB(0, 1), cB + hstepB, voffB); PG8_STAGE(PG8_SA(0, 0), cA, voffA); PG8_STAGE(PG8_SA(0, 1), cA + hstepA, voffA);
        if (wr == 1) PG8_BAR;
        PG8_WAIT_V(2); PG8_BAR;
        PG8_STAGE(PG8_SB(1, 0), cB + kstep, voffB); PG8_STAGE(PG8_SA(1, 0), cA + kstep, voffA); PG8_STAGE(PG8_SB(1, 1), cB + hstepB + kstep, voffB);
        PG8_WAIT_V(6); PG8_BAR;
    } else {
        PG8_STAGE(PG8_SB(0, 0), cB, voffB); PG8_STAGE(PG8_SA(0, 0), cA, voffA); PG8_STAGE(PG8_SB(0, 1), cB + hstepB, voffB); PG8_STAGE(PG8_SA(0, 1), cA + hstepA, voffA);
        if (wr == 1) PG8_BAR;
        PG8_WAIT_V(4); PG8_BAR;
        PG8_STAGE(PG8_SB(1, 0), cB + kstep, voffB); PG8_STAGE(PG8_SA(1, 0), cA + kstep, voffA); PG8_STAGE(PG8_SB(1, 1), cB + hstepB + kstep, voffB);
        PG8_WAIT_V(6); PG8_BAR;
    }
    for (;;) {
        const bool has_next = S.next(ui + 1, nxt);
        const char* nA = has_next ? (const char*)g.A + (size_t)nxt.pm * tstepA : cA; const char* nB = has_next ? (const char*)g.Bt + (size_t)nxt.pn * tstepB : cB;
        for (int t = 0; t < nt; t += 2) {
            const bool last = (t == nt - 2);
            const char* a1 = cA + (size_t)(t + 1) * kstep;
            const char* a2 = last ? nA : cA + (size_t)(t + 2) * kstep; const char* b2 = last ? nB : cB + (size_t)(t + 2) * kstep;
            const char* a3 = a2 + kstep; const char* b3 = b2 + kstep;
            if (last && has_next) S.a_ready(nxt);
            if constexpr (SP2) {
            PG8_LDB(B0, 0, 0); PG8_LDB(B1, 0, 1); PG8_SCHED; PG8_LDA(At, 0, 0); PG8_STAGE(PG8_SA(1, 1), a1 + hstepA, voffA);
            PG8_WAIT_V(8); PG8_WAIT_L(0); PG8_BAR; PG8_MMA(0, 0, At, B0); PG8_MMA(0, 1, At, B1); PG8_BAR; PG8_SCHED;
            PG8_LDA(At, 0, 1); PG8_STAGE(PG8_SB(0, 0), b2, voffB); PG8_STAGE(PG8_SB(0, 1), b2 + hstepB, voffB); PG8_STAGE(PG8_SA(0, 0), a2, voffA);
            PG8_WAIT_V(8); PG8_WAIT_L(0); PG8_BAR; PG8_MMA(1, 0, At, B0); PG8_MMA(1, 1, At, B1); PG8_BAR; PG8_SCHED;
            PG8_LDB(B0, 1, 0); PG8_LDB(B1, 1, 1); PG8_SCHED; PG8_LDA(At, 1, 0); PG8_STAGE(PG8_SA(0, 1), a2 + hstepA, voffA);
            PG8_WAIT_V(8); PG8_WAIT_L(0); PG8_BAR; PG8_MMA(0, 0, At, B0); PG8_MMA(0, 1, At, B1); PG8_BAR; PG8_SCHED;
            PG8_LDA(At, 1, 1); PG8_STAGE(PG8_SB(1, 0), b3, voffB); PG8_STAGE(PG8_SB(1, 1), b3 + hstepB, voffB); PG8_STAGE(PG8_SA(1, 0), a3, voffA);
            PG8_WAIT_V(8); PG8_WAIT_L(0); PG8_BAR; PG8_MMA(1, 0, At, B0); PG8_MMA(1, 1, At, B1); PG8_BAR; PG8_SCHED;
            } else {
            PG8_LDB(B0, 0, 0); PG8_SCHED; PG8_LDA(At, 0, 0); PG8_STAGE(PG8_SA(1, 1), a1 + hstepA, voffA);
            PG8_WAIT_L(8); PG8_BAR; PG8_WAIT_L(0); PG8_MMA(0, 0, At, B0); PG8_BAR; PG8_SCHED;
            PG8_LDB(B1, 0, 1); PG8_STAGE(PG8_SB(0, 0), b2, voffB);
            PG8_BAR; PG8_WAIT_L(0); PG8_MMA(0, 1, At, B1); PG8_BAR;
            PG8_LDA(At, 0, 1); PG8_STAGE(PG8_SA(0, 0), a2, voffA);
            PG8_BAR; PG8_WAIT_L(0); PG8_MMA(1, 0, At, B0); PG8_BAR; PG8_SCHED;
            PG8_STAGE(PG8_SB(0, 1), b2 + hstepB, voffB);
            PG8_WAIT_V(6); PG8_BAR; PG8_MMA(1, 1, At, B1); PG8_BAR;
            PG8_LDB(B0, 1, 0); PG8_SCHED; PG8_LDA(At, 1, 0); PG8_STAGE(PG8_SA(0, 1), a2 + hstepA, voffA);
            PG8_WAIT_L(8); PG8_BAR; PG8_WAIT_L(0); PG8_MMA(0, 0, At, B0); PG8_BAR; PG8_SCHED;
            PG8_LDB(B1, 1, 1); PG8_STAGE(PG8_SB(1, 0), b3, voffB);
            PG8_BAR; PG8_WAIT_L(0); PG8_MMA(0, 1, At, B1); PG8_BAR;
            PG8_LDA(At, 1, 1); PG8_STAGE(PG8_SA(1, 0), a3, voffA);
            PG8_BAR; PG8_WAIT_L(0); PG8_MMA(1, 0, At, B0); PG8_BAR; PG8_SCHED;
            PG8_STAGE(PG8_SB(1, 1), b3 + hstepB, voffB);
            PG8_WAIT_V(6); PG8_BAR; PG8_MMA(1, 1, At, B1); PG8_BAR;
            }
        }
        if constexpr (ALIGN_EPI) { if (wr == 0) PG8_BAR; }
        if constexpr (!Epi::AFTER_DRAIN) {
            const int l2 = lane_id_asm(); E(acc, cur, wr, wc, l2 & 15, l2 >> 4); S.done(cur); }
        if (!has_next) break;
#pragma unroll
        for (int a = 0; a < 2; ++a)
#pragma unroll
            for (int b = 0; b < 2; ++b)
#pragma unroll
                for (int m = 0; m < 4; ++m)
#pragma unroll
                    for (int n = 0; n < 2; ++n) acc[a][b][m][n] = (f32x4){0.f, 0.f, 0.f, 0.f};
        cur = nxt; cA = nA; cB = nB; ++ui;
        if constexpr (ALIGN_EPI) { if (wr == 1) PG8_BAR; }
    }
    PG8_WAIT_V(0);
    if constexpr (!ALIGN_EPI) { if (wr == 0) PG8_BAR; }
    PG8_BAR;
    if constexpr (Epi::AFTER_DRAIN) { E.fused(acc, cur, wr, wc, fr, fq, lds, wid, lane); S.done(cur); }
#undef PG8_SA
#undef PG8_SB
#undef PG8_STAGE
#undef PG8_LDA
#undef PG8_LDB
#undef PG8_MMA
#undef PG8_WAIT_V
#undef PG8_WAIT_L
#undef PG8_BAR
#undef PG8_SCHED
}
}

namespace pg8 {
typedef unsigned u32x2 __attribute__((ext_vector_type(2)));
typedef _Float16 f16x8 __attribute__((ext_vector_type(8)));
__device__ __forceinline__ float sigmoidf_(float x) { return __builtin_amdgcn_rcpf(1.0f + __expf(-x)); }
__device__ __forceinline__ float bf_lo(unsigned w) { return __uint_as_float(w << 16); }
__device__ __forceinline__ float bf_hi(unsigned w) { return __uint_as_float(w & 0xffff0000u); }

struct EpiZ1 {
    static constexpr bool PERM = true, AFTER_DRAIN = false;
    bf16_t* O;
    __device__ __forceinline__ void operator()(const f32x4 (&acc)[2][2][4][2], const Unit& u, int wr, int wc, int fr, int fq) const {
        const int row0 = u.pm * BM + wr * 64 + fr, col0 = u.pn * BM + wc * 32 + 8 * fq;
#pragma unroll
        for (int ai = 0; ai < 2; ++ai)
#pragma unroll
            for (int m = 0; m < 4; ++m) { bf16_t* rowp = O + (size_t)(row0 + ai * HALF + m * 16) * 4608 + col0;
#pragma unroll
                for (int bj = 0; bj < 2; ++bj) { f32x4 v0 = acc[ai][bj][m][0], v1 = acc[ai][bj][m][1];
                    if (bj == 0 && u.pn == 12) {
#pragma unroll
                        for (int j = 0; j < 4; ++j) { v0[j] = tanhf(v0[j]); v1[j] = tanhf(v1[j]); } }
                    if (bj == 0 && u.pn == 13) {
#pragma unroll
                        for (int j = 0; j < 4; ++j) { v0[j] = sigmoidf_(v0[j]); v1[j] = sigmoidf_(v1[j]); } }
                    u32x4 w; w.x = cvt_pk_bf16(v0[0], v0[1]); w.y = cvt_pk_bf16(v0[2], v0[3]); w.z = cvt_pk_bf16(v1[0], v1[1]); w.w = cvt_pk_bf16(v1[2], v1[3]);
                    *(u32x4*)(rowp + bj * HALF) = w; } }
    }
};
struct EpiZ2 {
    static constexpr bool PERM = true, AFTER_DRAIN = false;
    bf16_t* O; const float* cosT; const float* sinT;
    __device__ __forceinline__ void operator()(const f32x4 (&acc)[2][2][4][2], const Unit& u, int wr, int wc, int fr, int fq) const {
        const int row0 = u.pm * BM + wr * 64 + fr;
        if (u.pn >= 8) {
            const int col0 = u.pn * BM + wc * 32 + 8 * fq;
#pragma unroll
            for (int ai = 0; ai < 2; ++ai)
#pragma unroll
                for (int m = 0; m < 4; ++m) { bf16_t* rowp = O + (size_t)(row0 + ai * HALF + m * 16) * 3072 + col0;
#pragma unroll
                    for (int bj = 0; bj < 2; ++bj) { const f32x4 v0 = acc[ai][bj][m][0], v1 = acc[ai][bj][m][1];
                        u32x4 w; w.x = cvt_pk_bf16(v0[0], v0[1]); w.y = cvt_pk_bf16(v0[2], v0[3]); w.z = cvt_pk_bf16(v1[0], v1[1]); w.w = cvt_pk_bf16(v1[2], v1[3]);
                        *(u32x4*)(rowp + bj * HALF) = w; } }
            return;
        }
        const bool rope = u.pm < 128; const int axis = wc & 1;
        const int colg = u.pn * BM + wc * 32 + 4 * fq;
#pragma unroll
        for (int ai = 0; ai < 2; ++ai)
#pragma unroll
            for (int m = 0; m < 4; ++m) { const int row = row0 + ai * HALF + m * 16; bf16_t* rowp = O + (size_t)row * 3072 + colg;
                f32x4 cs = (f32x4){1.f, 1.f, 1.f, 1.f}, sn = (f32x4){0.f, 0.f, 0.f, 0.f};
                if (rope) { const int t = row & 4095, pos = axis ? (t & 63) : (t >> 6); cs = *(const f32x4*)(cosT + pos * 16 + 4 * fq); sn = *(const f32x4*)(sinT + pos * 16 + 4 * fq); }
#pragma unroll
                for (int bj = 0; bj < 2; ++bj) { const f32x4 a = acc[ai][bj][m][0], b = acc[ai][bj][m][1];
                    const f32x4 ra = a * cs - b * sn, rb = a * sn + b * cs;
                    u32x2 wa, wb; wa.x = cvt_pk_bf16(ra[0], ra[1]); wa.y = cvt_pk_bf16(ra[2], ra[3]); wb.x = cvt_pk_bf16(rb[0], rb[1]); wb.y = cvt_pk_bf16(rb[2], rb[3]);
                    *(u32x2*)(rowp + bj * HALF) = wa; *(u32x2*)(rowp + bj * HALF + 16) = wb; } }
    }
};
struct EpiGate {
    static constexpr bool PERM = true, AFTER_DRAIN = false;
    bf16_t* O;
    __device__ __forceinline__ void operator()(const f32x4 (&acc)[2][2][4][2], const Unit& u, int wr, int wc, int fr, int fq) const {
        const int row0 = u.pm * BM + wr * 64 + fr, col0 = u.pn * BM + wc * 32 + 8 * fq;
#pragma unroll
        for (int ai = 0; ai < 2; ++ai)
#pragma unroll
            for (int m = 0; m < 4; ++m) { bf16_t* rowp = O + (size_t)(row0 + ai * HALF + m * 16) * 6144 + col0;
#pragma unroll
                for (int bj = 0; bj < 2; ++bj) { f32x4 v0 = acc[ai][bj][m][0], v1 = acc[ai][bj][m][1];
#pragma unroll
                    for (int j = 0; j < 4; ++j) { v0[j] = sigmoidf_(v0[j]); v1[j] = sigmoidf_(v1[j]); }
                    u32x4 w; w.x = cvt_pk_bf16(v0[0], v0[1]); w.y = cvt_pk_bf16(v0[2], v0[3]); w.z = cvt_pk_bf16(v1[0], v1[1]); w.w = cvt_pk_bf16(v1[2], v1[3]);
                    *(u32x4*)(rowp + bj * HALF) = w; } }
    }
};
struct EpiLr {
    static constexpr bool PERM = true, AFTER_DRAIN = false;
    _Float16* O;
    __device__ __forceinline__ void operator()(const f32x4 (&acc)[2][2][4][2], const Unit& u, int wr, int wc, int fr, int fq) const {
        const int row0 = u.pm * BM + wr * 64 + fr, col0 = u.pn * BM + wc * 32 + 8 * fq;
#pragma unroll
        for (int bj = 0; bj < 2; ++bj)
#pragma unroll
            for (int ai = 0; ai < 2; ++ai)
#pragma unroll
                for (int m = 0; m < 4; ++m) { _Float16* rowp = O + (size_t)(row0 + ai * HALF + m * 16) * 5120 + col0 + bj * HALF;
                    const f32x4 v0 = acc[ai][bj][m][0], v1 = acc[ai][bj][m][1];
                    f16x8 w; w[0] = (_Float16)v0[0]; w[1] = (_Float16)v0[1]; w[2] = (_Float16)v0[2]; w[3] = (_Float16)v0[3]; w[4] = (_Float16)v1[0]; w[5] = (_Float16)v1[1]; w[6] = (_Float16)v1[2]; w[7] = (_Float16)v1[3];
                    *(f16x8*)rowp = w; asm volatile("" ::: "memory"); }
    }
};
template <int PASS> struct EpiMerge {
    static constexpr bool PERM = false, AFTER_DRAIN = false;
    const bf16_t* gates; bf16_t* accb;
    __device__ __forceinline__ void operator()(const f32x4 (&acc)[2][2][4][2], const Unit& u, int wr, int wc, int fr, int fq) const {
        const int row0 = u.pm * BM + wr * 64 + fr, col0 = u.pn * BM + wc * 32 + 4 * fq;
#pragma unroll
        for (int ai = 0; ai < 2; ++ai)
#pragma unroll
            for (int m = 0; m < 4; ++m) { const size_t row = (size_t)(row0 + ai * HALF + m * 16);
#pragma unroll
                for (int bj = 0; bj < 2; ++bj)
#pragma unroll
                    for (int n = 0; n < 2; ++n) { const int c = col0 + bj * HALF + n * 16;
                        const u32x2 gw = *(const u32x2*)(gates + row * 6144 + PASS * 2048 + c);
                        f32x4 v = acc[ai][bj][m][n]; v[0] *= bf_lo(gw.x); v[1] *= bf_hi(gw.x); v[2] *= bf_lo(gw.y); v[3] *= bf_hi(gw.y);
                        if (PASS != 0) { const u32x2 pw = *(const u32x2*)(accb + row * 2048 + c); v[0] += bf_lo(pw.x); v[1] += bf_hi(pw.x); v[2] += bf_lo(pw.y); v[3] += bf_hi(pw.y); }
                        u32x2 w; w.x = cvt_pk_bf16(v[0], v[1]); w.y = cvt_pk_bf16(v[2], v[3]); *(u32x2*)(accb + row * 2048 + c) = w; } }
    }
};
struct EpiRes {
    static constexpr bool PERM = false, AFTER_DRAIN = false;
    const float* xin_l; float* xout_l; const float* xin_c; float* xout_c; const float* mod; float gain;
    __device__ __forceinline__ void operator()(const f32x4 (&acc)[2][2][4][2], const Unit& u, int wr, int wc, int fr, int fq) const {
        const bool lat = u.pm < 128; const int prow = lat ? u.pm * BM : (u.pm - 128) * BM;
        const float* xi = lat ? xin_l : xin_c; float* xo = lat ? xout_l : xout_c; const float* mv = mod + (size_t)(lat ? (u.pm >> 4) : 8) * 12288;
        const int row0 = prow + wr * 64 + fr, col0 = u.pn * BM + wc * 32 + 4 * fq;
        f32x4 mvv[2][2];
#pragma unroll
        for (int bj = 0; bj < 2; ++bj)
#pragma unroll
            for (int n = 0; n < 2; ++n) mvv[bj][n] = *(const f32x4*)(mv + col0 + bj * HALF + n * 16);
#pragma unroll
        for (int ai = 0; ai < 2; ++ai)
#pragma unroll
            for (int m = 0; m < 4; ++m) { const size_t off = (size_t)(row0 + ai * HALF + m * 16) * 2048 + col0;
#pragma unroll
                for (int bj = 0; bj < 2; ++bj)
#pragma unroll
                    for (int n = 0; n < 2; ++n) { const f32x4 b = *(const f32x4*)(xi + off + bj * HALF + n * 16); *(f32x4*)(xo + off + bj * HALF + n * 16) = b + (mvv[bj][n] * gain) * acc[ai][bj][m][n]; } }
    }
};
struct EpiSwiglu {
    static constexpr bool PERM = true, AFTER_DRAIN = false;
    bf16_t* O;
    __device__ __forceinline__ void operator()(const f32x4 (&acc)[2][2][4][2], const Unit& u, int wr, int wc, int fr, int fq) const {
        const int row0 = u.pm * BM + wr * 64 + fr, col0 = u.pn * HALF + wc * 32 + 8 * fq;
#pragma unroll
        for (int ai = 0; ai < 2; ++ai)
#pragma unroll
            for (int m = 0; m < 4; ++m) { bf16_t* rowp = O + (size_t)(row0 + ai * HALF + m * 16) * 5632 + col0;
                f32x4 v0 = acc[ai][0][m][0], v1 = acc[ai][0][m][1]; const f32x4 u0 = acc[ai][1][m][0], u1 = acc[ai][1][m][1];
#pragma unroll
                for (int j = 0; j < 4; ++j) { v0[j] = v0[j] * sigmoidf_(v0[j]) * u0[j]; v1[j] = v1[j] * sigmoidf_(v1[j]) * u1[j]; }
                u32x4 w; w.x = cvt_pk_bf16(v0[0], v0[1]); w.y = cvt_pk_bf16(v0[2], v0[3]); w.z = cvt_pk_bf16(v1[0], v1[1]); w.w = cvt_pk_bf16(v1[2], v1[3]);
                *(u32x4*)rowp = w; }
    }
};
}

namespace att {
using bf16 = unsigned short;
using bf16x8 = __attribute__((ext_vector_type(8))) short;
using s16x4  = __attribute__((ext_vector_type(4))) short;
using f32x16 = __attribute__((ext_vector_type(16))) float;
using u32x4  = __attribute__((ext_vector_type(4))) unsigned;
constexpr int NW = 8, QBLK = 32, KVBLK = 64, LDZ = 3072;
constexpr float SCALE = 0.125f, THR = 8.f;
constexpr int SHM_V = KVBLK * 128 * 2, SHM_K = KVBLK * 64 * 2, SHM_ATTN = 2 * SHM_V + 2 * SHM_K + NW * 64 * 4;
#define ATT_KSWZ(row, colB) ((row) * 128 + ((colB) ^ ((((row) >> 1) & 7) << 4)))
#define ATT_SBAR() __builtin_amdgcn_sched_barrier(0)
__device__ __forceinline__ int crow(int r, int hi) { return (r & 3) + 8 * (r >> 2) + 4 * hi; }
typedef __bf16 bf16x2_t __attribute__((ext_vector_type(2)));
typedef float f32x2_t __attribute__((ext_vector_type(2)));
__device__ __forceinline__ unsigned cvtpk(float lo, float hi) { const f32x2_t v = {lo, hi}; const bf16x2_t b = __builtin_convertvector(v, bf16x2_t); return __builtin_bit_cast(unsigned, b); }
__device__ __forceinline__ bf16x8 ld8(const bf16* p) { return *reinterpret_cast<const bf16x8*>(p); }

__device__ __forceinline__ void partialSM(f32x16& p0, f32x16& p1, float& m_reg, float& mn, float& alpha) {
  constexpr float C = SCALE * 1.4426950408889634f;
  float pmax = p0[0];
#pragma unroll
  for (int r = 1; r < 16; ++r) pmax = fmaxf(pmax, p0[r]);
#pragma unroll
  for (int r = 0; r < 16; ++r) pmax = fmaxf(pmax, p1[r]);
  { auto rr = __builtin_amdgcn_permlane32_swap(__float_as_uint(pmax), __float_as_uint(pmax), false, false);
    pmax = fmaxf(__uint_as_float(rr[0]), __uint_as_float(rr[1])); }
  if (__builtin_expect(__all(pmax - m_reg <= THR / SCALE), 1)) { mn = m_reg; alpha = 1.f; }
  else { mn = fmaxf(m_reg, pmax); alpha = __builtin_amdgcn_exp2f((m_reg - mn) * C); m_reg = mn; }
  const float mnC = -mn * C;
#pragma unroll
  for (int r = 0; r < 16; ++r) p0[r] = fmaf(p0[r], C, mnC);
#pragma unroll
  for (int r = 0; r < 16; ++r) p1[r] = fmaf(p1[r], C, mnC);
#pragma unroll
  for (int r = 0; r < 16; ++r) p0[r] = __builtin_amdgcn_exp2f(p0[r]);
}
__device__ __forceinline__ void finishSM(f32x16& p0, f32x16& p1, float alpha, float& l_reg, bf16x8& pa0, bf16x8& pa1, bf16x8& pa2, bf16x8& pa3) {
#pragma unroll
  for (int r = 0; r < 16; ++r) p1[r] = __builtin_amdgcn_exp2f(p1[r]);
  float ps = 0;
#pragma unroll
  for (int r = 0; r < 16; ++r) ps += p0[r];
#pragma unroll
  for (int r = 0; r < 16; ++r) ps += p1[r];
  { auto rr = __builtin_amdgcn_permlane32_swap(__float_as_uint(ps), __float_as_uint(ps), false, false);
    ps = __uint_as_float(rr[0]) + __uint_as_float(rr[1]); }
  l_reg = l_reg * alpha + ps;
#define ATT_PK4(P, BASE, OUT) do { unsigned a0 = cvtpk(P[BASE + 0], P[BASE + 1]), a1 = cvtpk(P[BASE + 2], P[BASE + 3]);   \
    unsigned b0 = cvtpk(P[BASE + 4], P[BASE + 5]), b1 = cvtpk(P[BASE + 6], P[BASE + 7]);                              \
    auto r0 = __builtin_amdgcn_permlane32_swap(a0, b0, false, false); auto r1 = __builtin_amdgcn_permlane32_swap(a1, b1, false, false); \
    u32x4 w = {r0[0], r1[0], r0[1], r1[1]}; OUT = *reinterpret_cast<bf16x8*>(&w); } while (0)
  ATT_PK4(p0, 0, pa0); ATT_PK4(p0, 8, pa1); ATT_PK4(p1, 0, pa2); ATT_PK4(p1, 8, pa3);
#undef ATT_PK4
}
__device__ __forceinline__ void qkt(f32x16& p0, f32x16& p1, const char* Ks, const bf16x8* qr, int r32, int hi) {
  p0 = f32x16{}; p1 = f32x16{};
#pragma unroll
  for (int d0 = 0; d0 < 4; ++d0) { const int cb = (d0 * 16 + hi * 8) * 2;
    const bf16x8 b0 = *reinterpret_cast<const bf16x8*>(Ks + ATT_KSWZ(r32, cb));
    const bf16x8 b1 = *reinterpret_cast<const bf16x8*>(Ks + ATT_KSWZ(32 + r32, cb));
    p0 = __builtin_amdgcn_mfma_f32_32x32x16_bf16(b0, qr[d0], p0, 0, 0, 0);
    p1 = __builtin_amdgcn_mfma_f32_32x32x16_bf16(b1, qr[d0], p1, 0, 0, 0); }
}
__device__ __forceinline__ int v_st(int k, int c) { const int kk = (k & ~0xC) | ((k & 4) << 1) | ((k & 8) >> 1); return ((kk >> 3) * 4 + (c >> 5)) * 512 + ((kk & 7) * 32 + (c & 31)) * 2; }
__device__ __forceinline__ int v_rd_base(int lane) { return ((lane & 3) << 3) | (((lane >> 2) & 3) << 6) | (((lane >> 4) & 1) << 5) | (((lane >> 5) & 1) << 8); }
constexpr int v_rd_off(int d0, int ks, int half) { return d0 * 512 + ks * 4096 + half * 2048; }
template <int OFF> __device__ __forceinline__ s16x4 tr_read(int vb) {
  s16x4 r; asm volatile("ds_read_b64_tr_b16 %0, %1 offset:%2" : "=&v"(r) : "v"(vb), "i"(OFF) : "memory"); return r;
}
template <int D0> __device__ __forceinline__ void pv_one(f32x16& od, int vb, bf16x8 pa0, bf16x8 pa1, bf16x8 pa2, bf16x8 pa3) {
  const s16x4 l0 = tr_read<v_rd_off(D0, 0, 0)>(vb), h0 = tr_read<v_rd_off(D0, 0, 1)>(vb), l1 = tr_read<v_rd_off(D0, 1, 0)>(vb), h1 = tr_read<v_rd_off(D0, 1, 1)>(vb);
  const s16x4 l2 = tr_read<v_rd_off(D0, 2, 0)>(vb), h2 = tr_read<v_rd_off(D0, 2, 1)>(vb), l3 = tr_read<v_rd_off(D0, 3, 0)>(vb), h3 = tr_read<v_rd_off(D0, 3, 1)>(vb);
  asm volatile("s_waitcnt lgkmcnt(0)" ::: "memory"); ATT_SBAR();
#define ATT_PK(L, H) (bf16x8){L[0], L[1], L[2], L[3], H[0], H[1], H[2], H[3]}
  od = __builtin_amdgcn_mfma_f32_32x32x16_bf16(pa0, ATT_PK(l0, h0), od, 0, 0, 0);
  od = __builtin_amdgcn_mfma_f32_32x32x16_bf16(pa1, ATT_PK(l1, h1), od, 0, 0, 0);
  od = __builtin_amdgcn_mfma_f32_32x32x16_bf16(pa2, ATT_PK(l2, h2), od, 0, 0, 0);
  od = __builtin_amdgcn_mfma_f32_32x32x16_bf16(pa3, ATT_PK(l3, h3), od, 0, 0, 0);
#undef ATT_PK
}
__device__ __forceinline__ void pv_d0(f32x16* o, int vb, bf16x8 pa0, bf16x8 pa1, bf16x8 pa2, bf16x8 pa3) {
  pv_one<0>(o[0], vb, pa0, pa1, pa2, pa3); pv_one<1>(o[1], vb, pa0, pa1, pa2, pa3); pv_one<2>(o[2], vb, pa0, pa1, pa2, pa3); pv_one<3>(o[3], vb, pa0, pa1, pa2, pa3);
}

template <int STREAM>
__device__ __forceinline__ void body(const bf16* __restrict__ Z2, int qrow0, int klat0, int kctx0, int nlat, int NT, int qoff, int koff, int voff,
                                     float* __restrict__ tmp, bf16* __restrict__ Ob  , float lam, const float* __restrict__ subg, float oscale, char* lds, int wave_s) {
  int tid_ = (wave_s << 6) | lane_id_asm(); asm volatile("" : "+v"(tid_));
  const int tid = tid_, wid = tid >> 6, lane = tid & 63, r32 = lane & 31, hi = lane >> 5;
  char* V_lds = lds; char* K_lds = lds + 2 * SHM_V;
  float* ws = (float*)(lds + 2 * SHM_V + 2 * SHM_K) + wid * 64; float* li_l = ws; float* al_l = ws + 32;
  float m_reg = -1e30f, l_reg = 0; f32x16 o[4] = {}; bf16x8 qr[4];
  const bf16* Qw = Z2 + (size_t)(qrow0 + wid * QBLK + r32) * LDZ + qoff + hi * 8;
#pragma unroll
  for (int d0 = 0; d0 < 4; ++d0) qr[d0] = ld8(Qw + d0 * 16);
  const int sr = tid >> 4, sc = (tid & 15) * 8, vst0 = v_st(sr, sc), vst1 = v_st(32 + sr, sc);
  const int kr = tid >> 3, kst = ATT_KSWZ(kr, (tid & 7) * 16), kcol = koff + (tid & 7) * 8;
  const int vb0 = (int)(uintptr_t)V_lds + v_rd_base(lane);
  struct { bf16x8 vs0, vs1, ks0; } sr_[2];
#define ATT_KROW(j) ((j) < nlat ? klat0 + 64 * (j) : kctx0 + 64 * ((j) - nlat))
#define ATT_SLOAD(i, j) do { const int _r0 = ATT_KROW(j); sr_[i].vs0 = ld8(Z2 + (size_t)(_r0 + sr) * LDZ + voff + sc); sr_[i].vs1 = ld8(Z2 + (size_t)(_r0 + 32 + sr) * LDZ + voff + sc); \
    sr_[i].ks0 = ld8(Z2 + (size_t)(_r0 + kr) * LDZ + kcol); } while (0)
#define ATT_SWRITE(b, i) do { *(bf16x8*)(V_lds + (b) * SHM_V + vst0) = sr_[i].vs0; *(bf16x8*)(V_lds + (b) * SHM_V + vst1) = sr_[i].vs1; \
    *(bf16x8*)(K_lds + (b) * SHM_K + kst) = sr_[i].ks0; } while (0)
#define ATT_SWAIT() asm volatile("s_waitcnt vmcnt(3)" ::: "memory")
#define ATT_RESC(a) do { if (__any((a) < 1.f)) { if (hi == 0) al_l[r32] = (a); asm volatile("s_waitcnt lgkmcnt(0)" ::: "memory"); \
    _Pragma("unroll") for (int d = 0; d < 4; ++d) _Pragma("unroll") for (int r = 0; r < 16; ++r) o[d][r] *= al_l[crow(r, hi)]; } } while (0)
  f32x16 pA0, pA1, pB0, pB1; float mnA, mnB, alA, alB; bf16x8 pa0, pa1, pa2, pa3;
  constexpr int SE = 0, SO = 1;
  __syncthreads();
  ATT_SLOAD(SE, 0); asm volatile("s_waitcnt vmcnt(0)" ::: "memory"); ATT_SWRITE(0, SE); __syncthreads();
  qkt(pA0, pA1, K_lds, qr, r32, hi); partialSM(pA0, pA1, m_reg, mnA, alA);
  ATT_SLOAD(SO, 1); if (2 < NT) ATT_SLOAD(SE, 2);
  ATT_SWAIT(); ATT_SWRITE(1, SO); __syncthreads();
  for (int j = 1; j + 1 < NT; j += 2) {
    ATT_SBAR(); qkt(pB0, pB1, K_lds + SHM_K, qr, r32, hi);
    finishSM(pA0, pA1, alA, l_reg, pa0, pa1, pa2, pa3); ATT_SBAR();
    ATT_SLOAD(SO, j + 2); ATT_SBAR();
    pv_d0(o, vb0, pa0, pa1, pa2, pa3); partialSM(pB0, pB1, m_reg, mnB, alB);
    __syncthreads(); ATT_SWAIT(); ATT_SWRITE(0, SE);
    ATT_RESC(alB); __syncthreads();
    ATT_SBAR(); qkt(pA0, pA1, K_lds, qr, r32, hi);
    finishSM(pB0, pB1, alB, l_reg, pa0, pa1, pa2, pa3); ATT_SBAR();
    if (j + 3 < NT) ATT_SLOAD(SE, j + 3); ATT_SBAR();
    pv_d0(o, vb0 + SHM_V, pa0, pa1, pa2, pa3); partialSM(pA0, pA1, m_reg, mnA, alA);
    __syncthreads(); ATT_SWAIT(); ATT_SWRITE(1, SO);
    ATT_RESC(alA); __syncthreads();
  }
  ATT_SBAR(); qkt(pB0, pB1, K_lds + SHM_K, qr, r32, hi);
  finishSM(pA0, pA1, alA, l_reg, pa0, pa1, pa2, pa3); ATT_SBAR();
  pv_d0(o, vb0, pa0, pa1, pa2, pa3); partialSM(pB0, pB1, m_reg, mnB, alB);
  __syncthreads(); ATT_RESC(alB);
  finishSM(pB0, pB1, alB, l_reg, pa0, pa1, pa2, pa3); ATT_SBAR();
  pv_d0(o, vb0 + SHM_V, pa0, pa1, pa2, pa3);
  if (hi == 0) li_l[r32] = l_reg; asm volatile("s_waitcnt lgkmcnt(0)" ::: "memory");
  float rli[16];
#pragma unroll
  for (int r = 0; r < 16; ++r) rli[r] = __builtin_amdgcn_rcpf(li_l[crow(r, hi)]);
  float* tw = tmp + (size_t)(wid * QBLK) * 128;
  if constexpr (STREAM == 0) {
#pragma unroll
    for (int r = 0; r < 16; ++r) { const int orow = crow(r, hi);
#pragma unroll
      for (int d0 = 0; d0 < 4; ++d0) tw[orow * 128 + d0 * 32 + r32] = o[d0][r] * rli[r]; }
  } else {
    float sg[4];
#pragma unroll
    for (int d0 = 0; d0 < 4; ++d0) sg[d0] = subg[d0 * 32 + r32] * oscale;
    bf16* Ow = Ob + (size_t)(wid * QBLK) * 1024;
#pragma unroll
    for (int r = 0; r < 16; ++r) { const int orow = crow(r, hi); float v[4]; float ss = 0.f;
#pragma unroll
      for (int d0 = 0; d0 < 4; ++d0) { v[d0] = tw[orow * 128 + d0 * 32 + r32] - lam * (o[d0][r] * rli[r]); ss += v[d0] * v[d0]; }
#pragma unroll
      for (int of = 1; of < 32; of <<= 1) ss += __shfl_xor(ss, of);
      const float rs = rsqrtf(ss * (1.f / 128.f) + 1e-5f);
#pragma unroll
      for (int d0 = 0; d0 < 4; ++d0) { const unsigned w = cvtpk(v[d0] * rs * sg[d0], 0.f); Ow[(size_t)orow * 1024 + d0 * 32 + r32] = (bf16)(w & 0xffffu); } }
  }
#undef ATT_KROW
#undef ATT_SLOAD
#undef ATT_SWRITE
#undef ATT_SWAIT
#undef ATT_RESC
}
}

#ifndef MK_SPLIT
#define MK_SPLIT 0
#endif
constexpr int DM = 2048, NB = 8, SEQ = 4096, CTXL = 256, DEPTH = 4, BW = 1024;
constexpr int ML = NB * SEQ, MC = NB * CTXL, MT = ML + MC;
constexpr int DIN = 13696, N1 = 4608, N2 = 3072, N3 = 6144, NLR = 5120, KLR = 384, DFF = 5632, NFI = 2 * DFF, NMODC = 6 * DM;
constexpr int NWAVES = 8, NTHR = 512;
constexpr int N_IN = 28;
enum { I_X = 0, I_C, I_CTX, I_CCTX, I_WADA, I_BADA, I_NORMG, I_WIN, I_CONV, I_DW0, I_DUP, I_A0, I_AUP, I_GUP, I_KK, I_KA, I_RK, I_LNW, I_LNB, I_POOLW, I_POOLS, I_LAMQK, I_SUBG, I_WBR, I_WOUT, I_WFI, I_WFO, I_FING };

constexpr size_t MiB = 1u << 20;
constexpr size_t WS_CTL = 0, CTL_ZERO_BYTES = 1 * MiB;
constexpr size_t WS_MODS = 1 * MiB;
constexpr size_t WS_MISC = 3 * MiB;
constexpr size_t WS_W1T = 4 * MiB;
constexpr size_t WS_W2T = WS_W1T + (size_t)N1 * DM * 2;
constexpr size_t WS_W3T = WS_W2T + (size_t)N2 * DM * 2;
constexpr size_t WS_WLRT = WS_W3T + (size_t)N3 * DM * 2;
constexpr size_t WS_WBT = WS_WLRT + (size_t)NLR * KLR * 2;
constexpr size_t WS_WOT = WS_WBT + (size_t)3 * DM * BW * 2;
constexpr size_t WS_WFIT = WS_WOT + (size_t)DM * DM * 2;
constexpr size_t WS_WFOT = WS_WFIT + (size_t)NFI * DM * 2;
constexpr size_t WS_H = WS_WFOT + (size_t)DM * DFF * 2;
constexpr size_t WS_Z = WS_H + (size_t)MT * DM * 2;
constexpr size_t WS_RKV = WS_Z + (size_t)MT * N3 * 2;
constexpr size_t WS_LR = WS_RKV + (size_t)MT * 3072 * 2;
constexpr size_t WS_Y2 = WS_LR + (size_t)MT * NLR * 2;
constexpr size_t WS_POOL = WS_Y2 + (size_t)2 * MT * BW * 2;
constexpr size_t WS_YA = WS_POOL + (size_t)MT * BW * 2;
constexpr size_t WS_YC = WS_YA + (size_t)MT * BW * 2;
constexpr size_t WS_XC = WS_YC + (size_t)MT * BW * 2;
constexpr size_t WS_ATMP = WS_XC + (size_t)MC * DM * 4;
constexpr size_t WS_W2ND = WS_ATMP + (size_t)256 * 256 * 128 * 4;
constexpr size_t WS_END = WS_W2ND + (WS_H - WS_W1T);
#define WSP(l) ((size_t)((l) & 1) * (WS_W2ND - WS_W1T))
static_assert(WS_W1T % 256 == 0 && WS_H % 256 == 0 && WS_Z % 256 == 0 && WS_LR % 256 == 0 && WS_ATMP % 256 == 0, "alignment");
static_assert((size_t)MT * DM * 2 <= (size_t)MT * 3072 * 2, "accb (bf16 [MT][2048]) aliases the post-conv r|k|v buffer");
constexpr int CW_BAR = 4096;

constexpr int RING_BYTES = 131072, LDSCTL_OFF = RING_BYTES, MISC_OFF = LDSCTL_OFF + 320, LDS_BYTES = 147456;

#define GAS __attribute__((address_space(1)))
#define LAS __attribute__((address_space(3)))
typedef unsigned short bf16;
typedef unsigned v4u __attribute__((ext_vector_type(4)));
typedef unsigned v2u __attribute__((ext_vector_type(2)));
typedef float f32x4 __attribute__((ext_vector_type(4)));
typedef float f32x2v __attribute__((ext_vector_type(2)));
typedef _Float16 h2 __attribute__((ext_vector_type(2)));
#define LDS_WAIT() asm volatile("s_waitcnt lgkmcnt(0)" ::: "memory")
#define WG_BAR_LDS() do { asm volatile("s_waitcnt lgkmcnt(0)" ::: "memory"); __builtin_amdgcn_s_barrier(); asm volatile("" ::: "memory"); } while (0)
__device__ __forceinline__ unsigned f2bf(float f) { unsigned u = __builtin_bit_cast(unsigned, f); return (u + 0x7fffu + ((u >> 16) & 1u)) >> 16; }
__device__ __forceinline__ unsigned pk2(float lo, float hi) { return f2bf(lo) | (f2bf(hi) << 16); }
__device__ __forceinline__ float bflo(unsigned w) { return __uint_as_float(w << 16); }
__device__ __forceinline__ float bfhi(unsigned w) { return __uint_as_float(w & 0xffff0000u); }

__device__ __forceinline__ int opaque_s(int x) { asm volatile("" : "+s"(x)); return x; }
__device__ __forceinline__ int opaque_tid(int wave_s) { int t = (wave_s << 6) | lane_id_asm(); asm volatile("" : "+v"(t)); return t; }

#define XB_TMO      128
#define XB_XCNT(j)  (256  + 64 * (j))
#define XB_XSUB(j)  (1280 + 64 * (j))
#define XB_XGEN(j)  (2304 + 64 * (j))
#define XB_TOP      3328
#define XB_TOPGEN   3392
#define XCD_BAR_WORDS 3456
#define XB_SPIN_CAP (1u << 18)

__device__ __forceinline__ unsigned xb_ld(unsigned* p)              { return __hip_atomic_load(p, __ATOMIC_RELAXED, __HIP_MEMORY_SCOPE_AGENT); }
__device__ __forceinline__ unsigned xb_add(unsigned* p, unsigned v) { return __hip_atomic_fetch_add(p, v, __ATOMIC_RELAXED, __HIP_MEMORY_SCOPE_AGENT); }
__device__ __forceinline__ unsigned xb_xcc_id() { return (unsigned)__builtin_amdgcn_s_getreg((3 << 11) | 20) & 0xFu; }
#define XB_SPIN(cond, bar) do { unsigned _sp = 0; while (cond) { __builtin_amdgcn_s_sleep(1); \
    if ((++_sp & 255u) == 0u) { if (xb_ld(&(bar)[XB_TMO])) break; if (_sp > XB_SPIN_CAP) { atomicAdd(&(bar)[XB_TMO], 1u); break; } } } } while (0)

struct XcdBarrier {
    unsigned* bar; unsigned x;
    volatile LAS unsigned* st;
};

__device__ __forceinline__ XcdBarrier xcd_barrier_post(unsigned* bar, volatile LAS unsigned* st, bool t0  ) {
    XcdBarrier b; b.bar = bar; b.x = xb_xcc_id(); b.st = st;
    if (t0) (void)xb_add(&bar[XB_XCNT(b.x)], 1u);
    return b;
}
__device__ __forceinline__ void xcd_barrier_complete(unsigned* bar, unsigned x, unsigned& nloc, unsigned& nx) {
    const unsigned G = gridDim.x * gridDim.y * gridDim.z;
    unsigned sum, cnt, mine, sp = 0u;
    for (;;) {
        sum = 0u; cnt = 0u; mine = 0u;
#pragma unroll
        for (unsigned j = 0; j < 16; ++j) { const unsigned c = xb_ld(&bar[XB_XCNT(j)]); sum += c; cnt += (c > 0u) ? 1u : 0u; mine = (j == x) ? c : mine; }
        if (sum == G) break;
        __builtin_amdgcn_s_sleep(1);
        if ((++sp & 255u) == 0u) { if (xb_ld(&bar[XB_TMO])) break; if (sp > XB_SPIN_CAP) { atomicAdd(&bar[XB_TMO], 1u); break; } }
    }
    nloc = mine > 0u ? mine : 1u; nx = cnt > 0u ? cnt : 1u;
}

__device__ __forceinline__ void xcd_barrier(const XcdBarrier& b, bool t0  ) {
    asm volatile("s_waitcnt vmcnt(0)" ::: "memory");
    __syncthreads();
    if (t0) {
        unsigned* bar = b.bar;
        __builtin_amdgcn_s_waitcnt(0);
        unsigned nloc = b.st[0], nx = b.st[1];
        if (nloc == 0u) { xcd_barrier_complete(bar, b.x, nloc, nx); b.st[0] = nloc; b.st[1] = nx; }
        const unsigned old = xb_add(&bar[XB_XSUB(b.x)], 1u);
        const unsigned gen = old / nloc;
        if (old + 1u == (gen + 1u) * nloc) {
            __builtin_amdgcn_fence(__ATOMIC_RELEASE, "agent");
            asm volatile("s_waitcnt vmcnt(0)" ::: "memory");
            const unsigned og = xb_add(&bar[XB_TOP], 1u);
            const unsigned tg = og / nx;
            if (og + 1u == (tg + 1u) * nx) xb_add(&bar[XB_TOPGEN], 1u);
            else XB_SPIN(xb_ld(&bar[XB_TOPGEN]) == tg, bar);
            __builtin_amdgcn_fence(__ATOMIC_ACQUIRE, "agent");
            xb_add(&bar[XB_XGEN(b.x)], 1u);
            asm volatile("s_waitcnt vmcnt(0)" ::: "memory");
        } else {
            XB_SPIN(xb_ld(&bar[XB_XGEN(b.x)]) == gen, bar);
            __builtin_amdgcn_fence(__ATOMIC_ACQUIRE, "agent");
            asm volatile("s_waitcnt vmcnt(0)" ::: "memory");
        }
    }
    __syncthreads();
}

struct Ctx {
    unsigned char* lds;
    int vcu, G, wave_s;
    const float* const __attribute__((address_space(4)))* ka;
    float* out; unsigned char* ws;
    __device__ __forceinline__ const float* inp(int i) const { const float* const __attribute__((address_space(4)))* p = ka; asm volatile("" : "+s"(p)); return p[i]; }
};

__device__ __forceinline__ void ph_mods(const Ctx& C) {
    const int tid = opaque_tid(C.wave_s), lane = tid & 63, wave = __builtin_amdgcn_readfirstlane(tid >> 6), cG = opaque_s(C.G), cvcu = opaque_s(C.vcu); (void)lane; (void)wave; (void)cG; (void)cvcu;

    float* sc = (float*)C.lds;
    float* red = sc + 9 * 2048;
    float* mods = (float*)(C.ws + WS_MODS);
    for (int i = tid; i < 9 * 2048; i += NTHR) { const int r = i >> 11, k = i & 2047; const float v = r < 8 ? C.inp(I_C)[r * 2048 + k] : C.inp(I_CCTX)[k]; sc[i] = v / (1.f + expf(-v)); }
    __syncthreads();
    for (int it = blockIdx.x; it < DEPTH * (NMODC / 64); it += gridDim.x) {
        const int l = it / (NMODC / 64), nb = it % (NMODC / 64);
        const float* W = C.inp(I_WADA) + (size_t)l * DM * NMODC + nb * 64 + lane;
        float acc[9];
#pragma unroll
        for (int r = 0; r < 9; ++r) acc[r] = 0.f;
        const int kbeg = wave * 256;
#pragma unroll 4
        for (int k4 = 0; k4 < 64; ++k4) { const int k = kbeg + 4 * k4;
            const float w0 = W[(size_t)k * NMODC], w1 = W[(size_t)(k + 1) * NMODC], w2 = W[(size_t)(k + 2) * NMODC], w3 = W[(size_t)(k + 3) * NMODC];
#pragma unroll
            for (int r = 0; r < 9; ++r) { const f32x4 s = *(const f32x4*)(sc + r * 2048 + k); acc[r] += s.x * w0 + s.y * w1 + s.z * w2 + s.w * w3; } }
#pragma unroll
        for (int r = 0; r < 9; ++r) red[(wave * 9 + r) * 64 + lane] = acc[r];
        __syncthreads();
        for (int i = tid; i < 9 * 64; i += NTHR) { const int r = i >> 6, cc = i & 63; float s = 0.f;
#pragma unroll
            for (int w = 0; w < 8; ++w) s += red[(w * 9 + r) * 64 + cc];
            mods[((size_t)l * 9 + r) * NMODC + nb * 64 + cc] = s + C.inp(I_BADA)[l * NMODC + nb * 64 + cc]; }
        __syncthreads();
    }
    if (blockIdx.x == 0) {
        float* cosT = (float*)(C.ws + WS_MISC); float* sinT = cosT + 1024; float* lamv = sinT + 1024;
        for (int i = tid; i < 1024; i += NTHR) { const int pos = i >> 4, f = i & 15; const float inv = powf(10000.0f, -(float)f / 16.0f), ang = (float)pos * inv; cosT[i] = cosf(ang); sinT[i] = sinf(ang); }
        if (tid < DEPTH) { const float* lq = C.inp(I_LAMQK) + tid * 256; float d0 = 0.f, d1 = 0.f;
            for (int i = 0; i < 64; ++i) { d0 += lq[i] * lq[64 + i]; d1 += lq[128 + i] * lq[192 + i]; }
            const float lam_init = 0.8f - 0.6f * expf(-0.3f * (float)tid);
            lamv[tid] = expf(d0) - expf(d1) + lam_init; }
    }
}

__device__ __forceinline__ void ph_norm(const Ctx& C, int l, int which, int Mrows) {
    const int tid = opaque_tid(C.wave_s), lane = tid & 63, wave = __builtin_amdgcn_readfirstlane(tid >> 6), cG = opaque_s(C.G), cvcu = opaque_s(C.vcu); (void)lane; (void)wave; (void)cG; (void)cvcu;

    const int gw = cvcu * NWAVES + wave, NGW = cG * NWAVES;
    const float* g = C.inp(I_NORMG) + (l * 2 + which) * DM;
    const float* mods = (const float*)(C.ws + WS_MODS) + (size_t)l * 9 * NMODC;
    const bool first = (l == 0 && which == 0);
    bf16* H = (bf16*)(C.ws + WS_H);
    f32x4 gv[8];
#pragma unroll
    for (int j = 0; j < 8; ++j) gv[j] = *(const f32x4*)(g + 4 * lane + 256 * j);
    for (int m = gw; m < Mrows; m += NGW) {
        const float* xr; int r;
        if (m < ML) { xr = (first ? C.inp(I_X) : C.out) + (size_t)m * DM; r = m >> 12; } else { xr = (first ? C.inp(I_CTX) : (const float*)(C.ws + WS_XC)) + (size_t)(m - ML) * DM; r = 8; }
        const float* shift = mods + (size_t)r * NMODC + (which ? 3 : 0) * DM; const float* scale = mods + (size_t)r * NMODC + (which ? 4 : 1) * DM;
        f32x4 v[8]; float s = 0.f;
#pragma unroll
        for (int j = 0; j < 8; ++j) { v[j] = *(const f32x4*)(xr + 4 * lane + 256 * j); s += (v[j].x * v[j].x + v[j].y * v[j].y) + (v[j].z * v[j].z + v[j].w * v[j].w); }
#pragma unroll
        for (int o = 1; o < 64; o <<= 1) s += __shfl_xor(s, o);
        const float rstd = rsqrtf(s * (1.f / DM) + 1e-6f);
        unsigned long long* o8 = (unsigned long long*)(H + (size_t)m * DM) + lane;
#pragma unroll
        for (int j = 0; j < 8; ++j) { const f32x4 sh = *(const f32x4*)(shift + 4 * lane + 256 * j), scv = *(const f32x4*)(scale + 4 * lane + 256 * j);
            const f32x4 y = (v[j] * rstd) * gv[j] * (scv + 1.0f) + sh;
            o8[64 * j] = (unsigned long long)pk2(y.x, y.y) | ((unsigned long long)pk2(y.z, y.w) << 32); }
    }
}
__device__ __forceinline__ void ph_final(const Ctx& C) {
    const int tid = opaque_tid(C.wave_s), lane = tid & 63, wave = __builtin_amdgcn_readfirstlane(tid >> 6), cG = opaque_s(C.G), cvcu = opaque_s(C.vcu); (void)lane; (void)wave; (void)cG; (void)cvcu;

    const int gw = cvcu * NWAVES + wave, NGW = cG * NWAVES;
    const float* g = C.inp(I_FING);
    for (int m = gw; m < ML; m += NGW) {
        float* xr = C.out + (size_t)m * DM; f32x4 v[8]; float s = 0.f;
#pragma unroll
        for (int j = 0; j < 8; ++j) { v[j] = *(const f32x4*)(xr + 4 * lane + 256 * j); s += (v[j].x * v[j].x + v[j].y * v[j].y) + (v[j].z * v[j].z + v[j].w * v[j].w); }
#pragma unroll
        for (int o = 1; o < 64; o <<= 1) s += __shfl_xor(s, o);
        const float rstd = rsqrtf(s * (1.f / DM) + 1e-6f);
#pragma unroll
        for (int j = 0; j < 8; ++j) { const f32x4 gv = *(const f32x4*)(g + 4 * lane + 256 * j); *(f32x4*)(xr + 4 * lane + 256 * j) = (v[j] * rstd) * gv; }
    }
}

template <class SrcFn>
__device__ __forceinline__ void tr_item(const float* W, int ldw, int ksrc0, const SrcFn& src, bf16* WT, int ldt, int n0, int kdst0, float* scr, int lane) {
    const int scol = src(n0 + (lane & 31));
#pragma unroll 8
    for (int i = 0; i < 32; ++i) { const int kk = 2 * i + (lane >> 5); scr[kk * 33 + (lane & 31)] = scol >= 0 ? W[(size_t)(ksrc0 + kk) * ldw + scol] : 0.f; }
    LDS_WAIT();
    const int c = lane & 7;
#pragma unroll
    for (int j = 0; j < 4; ++j) { const int n = (lane >> 3) + 8 * j; const float* s = scr + (8 * c) * 33 + n;
        v4u o; o.x = pk2(s[0 * 33], s[1 * 33]); o.y = pk2(s[2 * 33], s[3 * 33]); o.z = pk2(s[4 * 33], s[5 * 33]); o.w = pk2(s[6 * 33], s[7 * 33]);
        *(v4u*)(WT + (size_t)(n0 + n) * ldt + kdst0 + 8 * c) = o; }
    LDS_WAIT();
}
struct SrcOff { int off, lim; __device__ __forceinline__ int operator()(int n) const { return n < lim ? off + n : -1; } };
struct SrcQkv { __device__ __forceinline__ int operator()(int n) const {
    if (n >= 2048) return 6528 + (n - 2048); const int G = n >> 5, w = n & 31, u = w >> 3, nn = (w >> 2) & 1, j = w & 3; return 4480 + 32 * G + 16 * nn + 4 * u + j; } };
struct SrcFfi { __device__ __forceinline__ int operator()(int n) const { const int pn = n >> 8, bj = (n >> 7) & 1, c = n & 127; return bj * DFF + 128 * pn + c; } };

__device__ __forceinline__ void ph_wprep(const Ctx& C, int l, int sl_lo = 0, int sl_hi = 1, int nsl = 1, bool do_pool = true) {
    const int tid = opaque_tid(C.wave_s), lane = tid & 63, wave = __builtin_amdgcn_readfirstlane(tid >> 6), cG = opaque_s(C.G), cvcu = opaque_s(C.vcu); (void)lane; (void)wave; (void)cG; (void)cvcu;

    float* scr = (float*)(C.lds + wave * 16384);
    const int gw = cvcu * NWAVES + wave, NGW = cG * NWAVES;
    const float* win = C.inp(I_WIN) + (size_t)l * DM * DIN;
    constexpr int I1 = 32 * (N1 / 32), I2 = 32 * (N2 / 32), I3 = 32 * (N3 / 32), ILR = 6 * (NLR / 32), IB = 16 * 64, IO = 32 * 64, IFI = 32 * (NFI / 32), IFO = 88 * 64;
    constexpr int NITEMS = I1 + I2 + I3 + ILR + 2 * IB + IO + IFI + IFO;
    for (int it = gw, jord = 0; it < NITEMS; it += NGW, ++jord) {
        { const int jm = jord % nsl; if (jm < sl_lo || jm >= sl_hi) continue; }
        int r = it;
        if (r < I1) { const int kb = r / (N1 / 32), nb = r % (N1 / 32); tr_item(win, DIN, 64 * kb, SrcOff{0, 4480}, (bf16*)(C.ws + WSP(l) + WS_W1T), DM, 32 * nb, 64 * kb, scr, lane); continue; } r -= I1;
        if (r < I2) { const int kb = r / (N2 / 32), nb = r % (N2 / 32); tr_item(win, DIN, 64 * kb, SrcQkv{}, (bf16*)(C.ws + WSP(l) + WS_W2T), DM, 32 * nb, 64 * kb, scr, lane); continue; } r -= I2;
        if (r < I3) { const int kb = r / (N3 / 32), nb = r % (N3 / 32); tr_item(win, DIN, 64 * kb, SrcOff{7552, N3}, (bf16*)(C.ws + WSP(l) + WS_W3T), DM, 32 * nb, 64 * kb, scr, lane); continue; } r -= I3;
        if (r < ILR) { const int kb = r / (NLR / 32), nb = r % (NLR / 32), n0 = 32 * nb, reg = n0 >> 10;
            const bool valid = reg < 4 ? (kb == reg) : (kb >= 4);
            const float* W = reg < 2 ? C.inp(I_DUP) + (size_t)(l * 2 + reg) * 64 * BW : reg < 4 ? C.inp(I_AUP) + (size_t)(l * 2 + reg - 2) * 64 * BW : C.inp(I_GUP) + (size_t)l * 128 * BW;
            const int ks = reg < 4 ? 0 : 64 * (kb - 4);
            tr_item(W, BW, ks, SrcOff{valid ? -(reg << 10) : -(1 << 30), valid ? (1 << 30) : 0}, (bf16*)(C.ws + WSP(l) + WS_WLRT), KLR, n0, 64 * kb, scr, lane); continue; } r -= ILR;
        if (r < 2 * IB) { const int i = r / IB ? 2 : 0, q = r % IB, kb = q / 64, nb = q % 64;
            tr_item(C.inp(I_WBR) + (size_t)(l * 3 + i) * BW * DM, DM, 64 * kb, SrcOff{0, DM}, (bf16*)(C.ws + WSP(l) + WS_WBT) + (size_t)i * DM * BW, BW, 32 * nb, 64 * kb, scr, lane); continue; } r -= 2 * IB;
        if (r < IO) { const int kb = r / 64, nb = r % 64; tr_item(C.inp(I_WOUT) + (size_t)l * DM * DM, DM, 64 * kb, SrcOff{0, DM}, (bf16*)(C.ws + WSP(l) + WS_WOT), DM, 32 * nb, 64 * kb, scr, lane); continue; } r -= IO;
        if (r < IFI) { const int kb = r / (NFI / 32), nb = r % (NFI / 32); tr_item(C.inp(I_WFI) + (size_t)l * DM * NFI, NFI, 64 * kb, SrcFfi{}, (bf16*)(C.ws + WSP(l) + WS_WFIT), DM, 32 * nb, 64 * kb, scr, lane); continue; } r -= IFI;
        { const int kb = r / 64, nb = r % 64; tr_item(C.inp(I_WFO) + (size_t)l * DFF * DM, DM, 64 * kb, SrcOff{0, DM}, (bf16*)(C.ws + WSP(l) + WS_WFOT), DFF, 32 * nb, 64 * kb, scr, lane); }
    }
    __syncthreads();
    if (do_pool) { float* wbs = (float*)C.lds;
      const float* wb1 = C.inp(I_WBR) + (size_t)(l * 3 + 1) * BW * DM; bf16* WT = (bf16*)(C.ws + WSP(l) + WS_WBT) + (size_t)1 * DM * BW;
      for (int it = cvcu; it < 256; it += cG) { const int g = it >> 6, n0 = (it & 63) * 32;
          for (int i = tid; i < 8192; i += NTHR) { const int d = i >> 5, nn = i & 31; wbs[i] = C.inp(I_POOLS)[l * BW + g * 256 + d] * wb1[(size_t)(g * 256 + d) * DM + n0 + nn]; }
          __syncthreads();
          const int c = tid & 255, nh = tid >> 8; const float* pw = C.inp(I_POOLW) + ((size_t)(l * 4 + g) * 256 + c) * 256;
          float acc[16];
#pragma unroll
          for (int j = 0; j < 16; ++j) acc[j] = 0.f;
          for (int d4 = 0; d4 < 64; ++d4) { const f32x4 p = *(const f32x4*)(pw + 4 * d4);
#pragma unroll
              for (int q = 0; q < 4; ++q) { const float pv = p[q]; const float* wr = wbs + (4 * d4 + q) * 32 + 16 * nh;
#pragma unroll
                  for (int j4 = 0; j4 < 4; ++j4) { const f32x4 w = *(const f32x4*)(wr + 4 * j4); acc[4 * j4] += pv * w.x; acc[4 * j4 + 1] += pv * w.y; acc[4 * j4 + 2] += pv * w.z; acc[4 * j4 + 3] += pv * w.w; } } }
#pragma unroll
          for (int j = 0; j < 16; ++j) WT[(size_t)(n0 + 16 * nh + j) * BW + g * 256 + c] = (bf16)f2bf(acc[j]);
          __syncthreads(); } }
}

__device__ __forceinline__ void ph_convpool(const Ctx& C, int l) {
    const int tid = opaque_tid(C.wave_s), lane = tid & 63, wave = __builtin_amdgcn_readfirstlane(tid >> 6), cG = opaque_s(C.G), cvcu = opaque_s(C.vcu); (void)lane; (void)wave; (void)cG; (void)cvcu;

    const bf16* z1 = (const bf16*)(C.ws + WS_Z); bf16* rkv = (bf16*)(C.ws + WS_RKV); bf16* pooled = (bf16*)(C.ws + WS_POOL);
    const int per = (MT + cG - 1) / cG, m0 = cvcu * per, m1 = (m0 + per < MT) ? m0 + per : MT;
    if (tid < 384) {
        const int col = tid * 8; const float* cw = C.inp(I_CONV) + (size_t)l * 3 * 3072 + col;
        float w[3][8];
#pragma unroll
        for (int j = 0; j < 3; ++j) { const f32x4 a = *(const f32x4*)(cw + j * 3072), b = *(const f32x4*)(cw + j * 3072 + 4); w[j][0] = a.x; w[j][1] = a.y; w[j][2] = a.z; w[j][3] = a.w; w[j][4] = b.x; w[j][5] = b.y; w[j][6] = b.z; w[j][7] = b.w; }
        int m = m0;
        for (; m + 8 <= m1; m += 8) {
            const int t0 = m < ML ? (m & 4095) : ((m - ML) & 255), n = m < ML ? SEQ : CTXL;
            v4u z[10];
#pragma unroll
            for (int r = 0; r < 10; ++r) { int mr = m - 1 + r; mr = mr < 0 ? 0 : (mr > MT - 1 ? MT - 1 : mr); z[r] = *(const v4u*)(z1 + (size_t)mr * N1 + col); }
#pragma unroll
            for (int r = 0; r < 8; ++r) { const bool hp = (t0 + r > 0), hn = (t0 + r < n - 1); v4u o;
#pragma unroll
                for (int q = 0; q < 4; ++q) { const unsigned zpq = hp ? z[r][q] : 0u, znq = hn ? z[r + 2][q] : 0u, zcq = z[r + 1][q];
                    const float lo = w[0][2 * q] * bflo(zpq) + w[1][2 * q] * bflo(zcq) + w[2][2 * q] * bflo(znq);
                    const float hi = w[0][2 * q + 1] * bfhi(zpq) + w[1][2 * q + 1] * bfhi(zcq) + w[2][2 * q + 1] * bfhi(znq); o[q] = pk2(lo, hi); }
                *(v4u*)(rkv + (size_t)(m + r) * 3072 + col) = o; }
        }
        for (; m < m1; ++m) {
            const int t = m < ML ? (m & 4095) : ((m - ML) & 255), n = m < ML ? SEQ : CTXL;
            const v4u zc = *(const v4u*)(z1 + (size_t)m * N1 + col);
            v4u zp = (v4u){0u, 0u, 0u, 0u}, zn = (v4u){0u, 0u, 0u, 0u};
            if (t > 0) zp = *(const v4u*)(z1 + (size_t)(m - 1) * N1 + col);
            if (t < n - 1) zn = *(const v4u*)(z1 + (size_t)(m + 1) * N1 + col);
            v4u o;
#pragma unroll
            for (int q = 0; q < 4; ++q) { const float lo = w[0][2 * q] * bflo(zp[q]) + w[1][2 * q] * bflo(zc[q]) + w[2][2 * q] * bflo(zn[q]);
                const float hi = w[0][2 * q + 1] * bfhi(zp[q]) + w[1][2 * q + 1] * bfhi(zc[q]) + w[2][2 * q + 1] * bfhi(zn[q]); o[q] = pk2(lo, hi); }
            *(v4u*)(rkv + (size_t)m * 3072 + col) = o;
        }
    } else {
        const int col = (tid - 384) * 8, gi = col >> 8, half = 1 << gi;
        float s[8];
#pragma unroll
        for (int q = 0; q < 8; ++q) s[q] = 0.f;
        int m = m0;
        for (; m + 8 <= m1; m += 8) {
            const int t0 = m < ML ? (m & 4095) : ((m - ML) & 255), n = m < ML ? SEQ : CTXL;
            const bf16* zb = z1 + (size_t)(m - t0) * N1 + 3456 + col;
            v4u zi[8], zo[8], zc[8];
#pragma unroll
            for (int r = 0; r < 8; ++r) { const int t = t0 + r; int ti = t - 1 + half, to = t - 1 - half; ti = ti > n - 1 ? n - 1 : ti; to = to < 0 ? 0 : to;
                zi[r] = *(const v4u*)(zb + (size_t)ti * N1); zo[r] = *(const v4u*)(zb + (size_t)to * N1); zc[r] = *(const v4u*)(zb + (size_t)t * N1); }
            if (m == m0 || t0 == 0) {
                const int lo = t0 - half > 0 ? t0 - half : 0, hi = t0 + half < n ? t0 + half : n;
#pragma unroll
                for (int q = 0; q < 8; ++q) s[q] = 0.f;
                for (int tt = lo; tt < hi; ++tt) { const v4u z = *(const v4u*)(zb + (size_t)tt * N1);
#pragma unroll
                    for (int q = 0; q < 4; ++q) { s[2 * q] += bflo(z[q]); s[2 * q + 1] += bfhi(z[q]); } }
            } else {
                const bool vi = (t0 - 1 + half < n), vo = (t0 - 1 - half >= 0);
#pragma unroll
                for (int q = 0; q < 4; ++q) { const unsigned a = vi ? zi[0][q] : 0u, b2 = vo ? zo[0][q] : 0u; s[2 * q] += bflo(a) - bflo(b2); s[2 * q + 1] += bfhi(a) - bfhi(b2); }
            }
#pragma unroll
            for (int r = 0; r < 8; ++r) { const int t = t0 + r;
                if (r > 0) { const bool vi = (t - 1 + half < n), vo = (t - 1 - half >= 0);
#pragma unroll
                    for (int q = 0; q < 4; ++q) { const unsigned a = vi ? zi[r][q] : 0u, b2 = vo ? zo[r][q] : 0u; s[2 * q] += bflo(a) - bflo(b2); s[2 * q + 1] += bfhi(a) - bfhi(b2); } }
                const int lo = t - half > 0 ? t - half : 0, hi = t + half < n ? t + half : n; const float inv = 1.f / (float)(hi - lo);
                v4u o;
#pragma unroll
                for (int q = 0; q < 4; ++q) o[q] = pk2(s[2 * q] * inv - bflo(zc[r][q]), s[2 * q + 1] * inv - bfhi(zc[r][q]));
                *(v4u*)(pooled + (size_t)(m + r) * BW + col) = o; }
        }
        for (; m < m1; ++m) {
            const int t = m < ML ? (m & 4095) : ((m - ML) & 255), n = m < ML ? SEQ : CTXL;
            const bf16* zb = z1 + (size_t)(m - t) * N1 + 3456 + col;
            const int lo = t - half > 0 ? t - half : 0, hi = t + half < n ? t + half : n;
            if (m == m0 || t == 0) {
#pragma unroll
                for (int q = 0; q < 8; ++q) s[q] = 0.f;
                for (int tt = lo; tt < hi; ++tt) { const v4u z = *(const v4u*)(zb + (size_t)tt * N1);
#pragma unroll
                    for (int q = 0; q < 4; ++q) { s[2 * q] += bflo(z[q]); s[2 * q + 1] += bfhi(z[q]); } }
            } else {
                v4u zin = (v4u){0u, 0u, 0u, 0u}, zout = (v4u){0u, 0u, 0u, 0u};
                if (t - 1 + half < n) zin = *(const v4u*)(zb + (size_t)(t - 1 + half) * N1);
                if (t - 1 - half >= 0) zout = *(const v4u*)(zb + (size_t)(t - 1 - half) * N1);
#pragma unroll
                for (int q = 0; q < 4; ++q) { s[2 * q] += bflo(zin[q]) - bflo(zout[q]); s[2 * q + 1] += bfhi(zin[q]) - bfhi(zout[q]); }
            }
            const v4u zc = *(const v4u*)(zb + (size_t)t * N1); const float inv = 1.f / (float)(hi - lo);
            v4u o;
#pragma unroll
            for (int q = 0; q < 4; ++q) o[q] = pk2(s[2 * q] * inv - bflo(zc[q]), s[2 * q + 1] * inv - bfhi(zc[q]));
            *(v4u*)(pooled + (size_t)m * BW + col) = o;
        }
    }
}
__device__ __forceinline__ float fsigmoid(float x) { return __builtin_amdgcn_rcpf(1.0f + __expf(-x)); }
__device__ __forceinline__ float red8(float x) {
    x += __builtin_bit_cast(float, __builtin_amdgcn_update_dpp(0, __builtin_bit_cast(int, x), 0xB1, 0xF, 0xF, true));
    x += __builtin_bit_cast(float, __builtin_amdgcn_update_dpp(0, __builtin_bit_cast(int, x), 0x4E, 0xF, 0xF, true));
    x += __builtin_bit_cast(float, __builtin_amdgcn_update_dpp(0, __builtin_bit_cast(int, x), 0x141, 0xF, 0xF, true));
    return x;
}
__device__ __forceinline__ void ph_scan(const Ctx& C, int l) {
    float* op = (float*)C.lds;
    float* yb = op + 16 * 384;
    const bf16* rkv = (const bf16*)(C.ws + WS_RKV); const _Float16* lr = (const _Float16*)(C.ws + WS_LR); bf16* ydir = (bf16*)(C.ws + WS_Y2);
    const int tid = opaque_tid(C.wave_s), lane = tid & 63, wv = __builtin_amdgcn_readfirstlane(tid >> 6), ss = tid >> 5, cp = tid & 31;
    const int vl = lane >> 3, kq = lane & 7;
    for (int it = blockIdx.x; it < 256; it += gridDim.x) {
        const int b = it >> 5, h = (it >> 1) & 15, dir = it & 1, ch = h * 64 + 2 * cp;
        const float kks0 = C.inp(I_KK)[l * BW + ch], kks1 = C.inp(I_KK)[l * BW + ch + 1], ka0 = C.inp(I_KA)[l * BW + ch], ka1 = C.inp(I_KA)[l * BW + ch + 1];
        const float dw0 = C.inp(I_DW0)[(l * 2 + dir) * BW + ch], dw1 = C.inp(I_DW0)[(l * 2 + dir) * BW + ch + 1], ia0 = C.inp(I_A0)[(l * 2 + dir) * BW + ch], ia1 = C.inp(I_A0)[(l * 2 + dir) * BW + ch + 1];
        f32x2v S[4];
#pragma unroll
        for (int i = 0; i < 4; ++i) S[i] = (f32x2v){0.f, 0.f};
        unsigned rr, rk, rv; h2 rs, ra;
#define SCAN_ROW(g) ((g) < 256 ? (ML + b * 256 + (dir ? 255 - (g) : (g))) : (b * 4096 + (dir ? 4095 - ((g) - 256) : ((g) - 256))))
#define SCAN_LOAD(c) do { const size_t _row = (size_t)SCAN_ROW(16 * (c) + ss); rr = *(const unsigned*)(rkv + _row * 3072 + ch); rk = *(const unsigned*)(rkv + _row * 3072 + 1024 + ch); rv = *(const unsigned*)(rkv + _row * 3072 + 2048 + ch); \
        rs = *(const h2*)(lr + _row * NLR + dir * 1024 + ch); ra = *(const h2*)(lr + _row * NLR + 2048 + dir * 1024 + ch); } while (0)
        SCAN_LOAD(0);
        for (int c = 0; c < 272; ++c) {
            { const float k0 = bflo(rk), k1 = bfhi(rk), q0 = k0 * kks0, q1 = k1 * kks1; float sq = q0 * q0 + q1 * q1;
#pragma unroll
              for (int o = 1; o < 32; o <<= 1) sq += __shfl_xor(sq, o);
              const float inv = __builtin_amdgcn_rsqf(fmaxf(sq, 1e-24f)), n0 = q0 * inv, n1 = q1 * inv;
              const float a0 = fsigmoid((float)ra[0] + ia0), a1 = fsigmoid((float)ra[1] + ia1);
              const float sd0 = fsigmoid((float)rs[0] + dw0), sd1 = fsigmoid((float)rs[1] + dw1);
              float* o = op + ss * 384 + 2 * cp;
              *(f32x2v*)(o) = (f32x2v){-n0, -n1};
              *(f32x2v*)(o + 64) = (f32x2v){__expf(-0.60653065971f * sd0), __expf(-0.60653065971f * sd1)};
              *(f32x2v*)(o + 128) = (f32x2v){n0 * a0, n1 * a1};
              *(f32x2v*)(o + 192) = (f32x2v){k0 * (1.f + (a0 - 1.f) * ka0), k1 * (1.f + (a1 - 1.f) * ka1)};
              *(f32x2v*)(o + 256) = (f32x2v){bflo(rr), bfhi(rr)};
              *(f32x2v*)(o + 320) = (f32x2v){bflo(rv), bfhi(rv)}; }
            if (c + 1 < 272) SCAN_LOAD(c + 1);
            WG_BAR_LDS();
#pragma unroll
            for (int s = 0; s < 16; ++s) {
                const float* o = op + s * 384 + 8 * kq;
                const f32x4 a0 = *(const f32x4*)(o), a1 = *(const f32x4*)(o + 4), w0 = *(const f32x4*)(o + 64), w1 = *(const f32x4*)(o + 68), b0 = *(const f32x4*)(o + 128), b1 = *(const f32x4*)(o + 132);
                const f32x4 d0 = *(const f32x4*)(o + 192), d1 = *(const f32x4*)(o + 196), r0 = *(const f32x4*)(o + 256), r1 = *(const f32x4*)(o + 260);
                const float vv = op[s * 384 + 320 + 8 * wv + vl];
#define SC_LO(q) ((f32x2v){(q).x, (q).y})
#define SC_HI(q) ((f32x2v){(q).z, (q).w})
                f32x2v pa = S[0] * SC_LO(a0); pa = S[1] * SC_HI(a0) + pa; pa = S[2] * SC_LO(a1) + pa; pa = S[3] * SC_HI(a1) + pa;
                const float sa = red8(pa.x + pa.y);
                const f32x2v sa2 = (f32x2v){sa, sa}, vv2 = (f32x2v){vv, vv};
                S[0] = S[0] * SC_LO(w0) + (sa2 * SC_LO(b0) + vv2 * SC_LO(d0)); S[1] = S[1] * SC_HI(w0) + (sa2 * SC_HI(b0) + vv2 * SC_HI(d0));
                S[2] = S[2] * SC_LO(w1) + (sa2 * SC_LO(b1) + vv2 * SC_LO(d1)); S[3] = S[3] * SC_HI(w1) + (sa2 * SC_HI(b1) + vv2 * SC_HI(d1));
                f32x2v py = S[0] * SC_LO(r0); py = S[1] * SC_HI(r0) + py; py = S[2] * SC_LO(r1) + py; py = S[3] * SC_HI(r1) + py;
                const float y = red8(py.x + py.y);
#undef SC_LO
#undef SC_HI
                if (kq == 0) yb[s * 64 + 8 * wv + vl] = y;
            }
            WG_BAR_LDS();
            { const f32x2v acc = *(const f32x2v*)(yb + ss * 64 + 2 * cp);
              const size_t row = (size_t)SCAN_ROW(16 * c + ss);
              *(unsigned*)(ydir + ((size_t)dir * MT + row) * BW + ch) = pk2(acc.x, acc.y); }
        }
        WG_BAR_LDS();
#undef SCAN_LOAD
#undef SCAN_ROW
    }
}

#ifndef SCAN_CHUNKED
#define SCAN_CHUNKED 2
#endif
typedef short sc_bf16x8 __attribute__((ext_vector_type(8)));
constexpr int SC_LDL = 72, SC_LDJ = 40;
__device__ __forceinline__ sc_bf16x8 sc_frag(const bf16* base, int ld, int row, int k0) { return *(const sc_bf16x8*)(base + row * ld + k0); }
__device__ __forceinline__ void ph_scan_chunk(const Ctx& C, int l) {
    bf16* At = (bf16*)C.lds; bf16* Bt = At + 16 * SC_LDL; bf16* Kt = Bt + 16 * SC_LDL; bf16* Rt = Kt + 16 * SC_LDL;
    bf16* BhT = Rt + 16 * SC_LDL; bf16* KhT = BhT + 64 * SC_LDJ; bf16* Vt = KhT + 64 * SC_LDJ; bf16* Pt = Vt + 64 * SC_LDJ; bf16* Ut = Pt + 64 * SC_LDJ;
    bf16* Mak = Ut + 64 * SC_LDJ; bf16* Nrb = Mak + 16 * SC_LDJ; bf16* Nrk = Nrb + 16 * SC_LDJ; bf16* Tb = Nrk + 16 * SC_LDJ;
    bf16* Sb = Tb + 16 * SC_LDJ;
    float* Mf = (float*)(Sb + 64 * SC_LDL); float* lw = Mf + 16 * 17; float* gc = lw + 16 * 64;
    const bf16* rkv = (const bf16*)(C.ws + WS_RKV); const _Float16* lr = (const _Float16*)(C.ws + WS_LR); bf16* ydir = (bf16*)(C.ws + WS_Y2);
    const int tid = opaque_tid(C.wave_s), lane = tid & 63, wv = __builtin_amdgcn_readfirstlane(tid >> 6), ss = tid >> 5, cp = tid & 31;
    const int fr = lane & 15, fq = lane >> 4;
    for (int it = blockIdx.x; it < 256; it += gridDim.x) {
        const int b = it >> 5, h = (it >> 1) & 15, dir = it & 1, ch = h * 64 + 2 * cp;
        const float kks0 = C.inp(I_KK)[l * BW + ch], kks1 = C.inp(I_KK)[l * BW + ch + 1], ka0 = C.inp(I_KA)[l * BW + ch], ka1 = C.inp(I_KA)[l * BW + ch + 1];
        const float dw0 = C.inp(I_DW0)[(l * 2 + dir) * BW + ch], dw1 = C.inp(I_DW0)[(l * 2 + dir) * BW + ch + 1], ia0 = C.inp(I_A0)[(l * 2 + dir) * BW + ch], ia1 = C.inp(I_A0)[(l * 2 + dir) * BW + ch + 1];
        for (int i = tid; i < (int)((char*)Mf - (char*)BhT) / 4; i += NTHR) ((unsigned*)BhT)[i] = 0u;
        f32x4 S0 = (f32x4){0.f, 0.f, 0.f, 0.f}, S1 = S0;
        unsigned rr, rk, rv; h2 rs, ra;
#define SCAN_ROW(g) ((g) < 256 ? (ML + b * 256 + (dir ? 255 - (g) : (g))) : (b * 4096 + (dir ? 4095 - ((g) - 256) : ((g) - 256))))
#define SCAN_LOAD(c) do { const size_t _row = (size_t)SCAN_ROW(16 * (c) + ss); rr = *(const unsigned*)(rkv + _row * 3072 + ch); rk = *(const unsigned*)(rkv + _row * 3072 + 1024 + ch); rv = *(const unsigned*)(rkv + _row * 3072 + 2048 + ch); \
        rs = *(const h2*)(lr + _row * NLR + dir * 1024 + ch); ra = *(const h2*)(lr + _row * NLR + 2048 + dir * 1024 + ch); } while (0)
        SCAN_LOAD(0);
        WG_BAR_LDS();
        for (int c = 0; c < 272; ++c) {
            const float k0 = bflo(rk), k1 = bfhi(rk), q0 = k0 * kks0, q1 = k1 * kks1; float sq = q0 * q0 + q1 * q1;
#pragma unroll
            for (int o = 1; o < 32; o <<= 1) sq += __shfl_xor(sq, o);
            const float inv = __builtin_amdgcn_rsqf(fmaxf(sq, 1e-24f)), n0 = q0 * inv, n1 = q1 * inv;
            const float a0 = fsigmoid((float)ra[0] + ia0), a1 = fsigmoid((float)ra[1] + ia1), sd0 = fsigmoid((float)rs[0] + dw0), sd1 = fsigmoid((float)rs[1] + dw1);
            const float kd0 = k0 * (1.f + (a0 - 1.f) * ka0), kd1 = k1 * (1.f + (a1 - 1.f) * ka1), r0 = bflo(rr), r1 = bfhi(rr), v0 = bflo(rv), v1 = bfhi(rv);
            *(f32x2v*)(lw + ss * 64 + 2 * cp) = (f32x2v){-0.60653065971f * sd0, -0.60653065971f * sd1};
            if (c + 1 < 272) SCAN_LOAD(c + 1);
            WG_BAR_LDS();
            if (tid < 64) { float run = 0.f;
                float t[16];
#pragma unroll
                for (int s2 = 0; s2 < 16; ++s2) t[s2] = lw[s2 * 64 + tid];
#pragma unroll
                for (int s2 = 0; s2 < 16; ++s2) { run += t[s2]; lw[s2 * 64 + tid] = run; } }
            WG_BAR_LDS();
            { const f32x2v cum = *(const f32x2v*)(lw + ss * 64 + 2 * cp), c15 = *(const f32x2v*)(lw + 15 * 64 + 2 * cp);
              f32x2v cpr = (f32x2v){0.f, 0.f}; if (ss > 0) cpr = *(const f32x2v*)(lw + (ss - 1) * 64 + 2 * cp);
              const float G0 = __expf(cum.x), G1 = __expf(cum.y), P0 = __expf(cpr.x), P1 = __expf(cpr.y), I0 = __expf(-cum.x), I1 = __expf(-cum.y), E0 = __expf(c15.x - cum.x), E1 = __expf(c15.y - cum.y);
              *(unsigned*)(At + ss * SC_LDL + 2 * cp) = pk2(-n0 * P0, -n1 * P1);
              *(unsigned*)(Bt + ss * SC_LDL + 2 * cp) = pk2(n0 * a0 * I0, n1 * a1 * I1);
              *(unsigned*)(Kt + ss * SC_LDL + 2 * cp) = pk2(kd0 * I0, kd1 * I1);
              *(unsigned*)(Rt + ss * SC_LDL + 2 * cp) = pk2(r0 * G0, r1 * G1);
              BhT[(2 * cp) * SC_LDJ + ss] = (bf16)f2bf(n0 * a0 * E0); BhT[(2 * cp + 1) * SC_LDJ + ss] = (bf16)f2bf(n1 * a1 * E1);
              KhT[(2 * cp) * SC_LDJ + ss] = (bf16)f2bf(kd0 * E0);      KhT[(2 * cp + 1) * SC_LDJ + ss] = (bf16)f2bf(kd1 * E1);
              Vt[(2 * cp) * SC_LDJ + ss] = (bf16)f2bf(v0);             Vt[(2 * cp + 1) * SC_LDJ + ss] = (bf16)f2bf(v1);
              if (ss == 15) *(f32x2v*)(gc + 2 * cp) = (f32x2v){__expf(c15.x), __expf(c15.y)}; }
            WG_BAR_LDS();
            f32x4 accP = (f32x4){0.f, 0.f, 0.f, 0.f}, accY = accP;
            if (wv < 4) { const bf16* X = (wv < 2) ? At : Rt; const bf16* Y = (wv & 1) ? Kt : Bt; f32x4 m = (f32x4){0.f, 0.f, 0.f, 0.f};
#pragma unroll
                for (int ks = 0; ks < 2; ++ks) m = __builtin_amdgcn_mfma_f32_16x16x32_bf16(sc_frag(X, SC_LDL, fr, 32 * ks + 8 * fq), sc_frag(Y, SC_LDL, fr, 32 * ks + 8 * fq), m, 0, 0, 0);
#pragma unroll
                for (int e = 0; e < 4; ++e) { const int i = 4 * fq + e; const bool keep = (wv < 2) ? (fr < i) : (fr <= i); const float val = keep ? m[e] : 0.f;
                    if (wv == 0) Mf[i * 17 + fr] = val; else ((wv == 1) ? Mak : (wv == 2) ? Nrb : Nrk)[i * SC_LDJ + fr] = (bf16)f2bf(val); }
            } else { const int tv = wv - 4;
#pragma unroll
                for (int ks = 0; ks < 2; ++ks) { const sc_bf16x8 sb = sc_frag(Sb, SC_LDL, 16 * tv + fr, 32 * ks + 8 * fq);
                    accP = __builtin_amdgcn_mfma_f32_16x16x32_bf16(sc_frag(At, SC_LDL, fr, 32 * ks + 8 * fq), sb, accP, 0, 0, 0);
                    accY = __builtin_amdgcn_mfma_f32_16x16x32_bf16(sc_frag(Rt, SC_LDL, fr, 32 * ks + 8 * fq), sb, accY, 0, 0, 0); } }
            WG_BAR_LDS();
            if (wv >= 4) { const int tv = wv - 4; const sc_bf16x8 vb = sc_frag(Vt, SC_LDJ, 16 * tv + fr, 8 * fq);
                accP = __builtin_amdgcn_mfma_f32_16x16x32_bf16(sc_frag(Mak, SC_LDJ, fr, 8 * fq), vb, accP, 0, 0, 0);
                accY = __builtin_amdgcn_mfma_f32_16x16x32_bf16(sc_frag(Nrk, SC_LDJ, fr, 8 * fq), vb, accY, 0, 0, 0);
                float* Pf = (float*)Pt + tv * (16 * 17);
#pragma unroll
                for (int e = 0; e < 4; ++e) Pf[fr * 17 + 4 * fq + e] = accP[e];
                float mrow[16];
#pragma unroll
                for (int i = 0; i < 16; ++i) mrow[i] = Mf[i * 17 + fr];
                LDS_WAIT();
                float u[16];
#pragma unroll
                for (int i = 0; i < 16; ++i) { float acc = Pf[fr * 17 + i];
#pragma unroll
                    for (int jj = 0; jj < i; ++jj) acc += __builtin_bit_cast(float, __builtin_amdgcn_readlane(__builtin_bit_cast(int, mrow[i]), jj)) * u[jj];
                    u[i] = acc; }
                if (fq == 0) {
#pragma unroll
                    for (int i = 0; i < 16; i += 2) *(unsigned*)(Ut + (16 * tv + fr) * SC_LDJ + i) = pk2(u[i], u[i + 1]); }
                LDS_WAIT();
                accY = __builtin_amdgcn_mfma_f32_16x16x32_bf16(sc_frag(Nrb, SC_LDJ, fr, 8 * fq), sc_frag(Ut, SC_LDJ, 16 * tv + fr, 8 * fq), accY, 0, 0, 0);
#pragma unroll
                for (int e = 0; e < 4; ++e) { const size_t row = (size_t)SCAN_ROW(16 * c + 4 * fq + e);
                    ydir[((size_t)dir * MT + row) * BW + h * 64 + 16 * tv + fr] = (bf16)f2bf(accY[e]); } }
            WG_BAR_LDS();
            { const int tv = wv >> 1, tk = 2 * (wv & 1);
              const sc_bf16x8 ua = sc_frag(Ut, SC_LDJ, 16 * tv + fr, 8 * fq), va = sc_frag(Vt, SC_LDJ, 16 * tv + fr, 8 * fq);
              const float g0 = gc[16 * tk + fr], g1 = gc[16 * (tk + 1) + fr];
              S0 = S0 * g0; S1 = S1 * g1;
              S0 = __builtin_amdgcn_mfma_f32_16x16x32_bf16(ua, sc_frag(BhT, SC_LDJ, 16 * tk + fr, 8 * fq), S0, 0, 0, 0);
              S0 = __builtin_amdgcn_mfma_f32_16x16x32_bf16(va, sc_frag(KhT, SC_LDJ, 16 * tk + fr, 8 * fq), S0, 0, 0, 0);
              S1 = __builtin_amdgcn_mfma_f32_16x16x32_bf16(ua, sc_frag(BhT, SC_LDJ, 16 * (tk + 1) + fr, 8 * fq), S1, 0, 0, 0);
              S1 = __builtin_amdgcn_mfma_f32_16x16x32_bf16(va, sc_frag(KhT, SC_LDJ, 16 * (tk + 1) + fr, 8 * fq), S1, 0, 0, 0);
#pragma unroll
              for (int e = 0; e < 4; ++e) { Sb[(16 * tv + 4 * fq + e) * SC_LDL + 16 * tk + fr] = (bf16)f2bf(S0[e]); Sb[(16 * tv + 4 * fq + e) * SC_LDL + 16 * (tk + 1) + fr] = (bf16)f2bf(S1[e]); } }
            WG_BAR_LDS();
        }
#undef SCAN_LOAD
#undef SCAN_ROW
    }
}

typedef _Float16 h4 __attribute__((ext_vector_type(4)));
struct __attribute__((aligned(8))) u32x2 { unsigned x, y; };
#define DPP_F(x, ctrl) __builtin_bit_cast(float, __builtin_amdgcn_update_dpp(0, __builtin_bit_cast(int, (x)), (ctrl), 0xF, 0xF, true))
constexpr int WSO_BYTES = 4 * 16 * SC_LDL * 2 + 3 * 64 * SC_LDJ * 2 + 256;
constexpr int WSX_BYTES = 16 * 17 * 4 + 3 * 16 * SC_LDJ * 2;
constexpr int WSC_BYTES = 16 * SC_LDL * 2 + 16 * 20 * 4 + 16 * SC_LDJ * 2;
constexpr int WS_SCAN_LDS = 3 * WSO_BYTES + 2 * WSX_BYTES + 4 * WSC_BYTES;
static_assert(WS_SCAN_LDS + 256 <= RING_BYTES && WSO_BYTES % 16 == 0 && WSX_BYTES % 16 == 0 && WSC_BYTES % 16 == 0, "scan LDS carve");
__device__ __forceinline__ void ph_scan_ws(const Ctx& C, int l) {
    unsigned char* const L = C.lds; float* const kkt = (float*)(L + WS_SCAN_LDS);
    const bf16* rkv = (const bf16*)(C.ws + WS_RKV); const _Float16* lr = (const _Float16*)(C.ws + WS_LR); bf16* ydir = (bf16*)(C.ws + WS_Y2);
    const int tid = opaque_tid(C.wave_s), lane = tid & 63, wv = __builtin_amdgcn_readfirstlane(tid >> 6);
    const int fr = lane & 15, fq = lane >> 4;
    for (int it = blockIdx.x; it < 256; it += gridDim.x) {
        const int b = it >> 5, h = (it >> 1) & 15, dir = it & 1;
        for (int i = tid; i < WS_SCAN_LDS / 4; i += NTHR) ((unsigned*)L)[i] = 0u;
        if (tid < 64) kkt[tid] = C.inp(I_KK)[l * BW + h * 64 + tid];
        WG_BAR_LDS();
#define SCAN_ROW(g) ((g) < 256 ? (ML + b * 256 + (dir ? 255 - (g) : (g))) : (b * 4096 + (dir ? 4095 - ((g) - 256) : ((g) - 256))))
        if (wv < 4) {
            const int cl = 16 * wv + 4 * fq, c0 = h * 64 + cl;
            float kko[4], kav[4], dwv[4], iav[4], kkn[16];
#pragma unroll
            for (int j = 0; j < 4; ++j) { kko[j] = kkt[cl + j]; kav[j] = C.inp(I_KA)[l * BW + c0 + j]; dwv[j] = C.inp(I_DW0)[(l * 2 + dir) * BW + c0 + j]; iav[j] = C.inp(I_A0)[(l * 2 + dir) * BW + c0 + j]; }
#pragma unroll
            for (int j = 0; j < 16; ++j) kkn[j] = kkt[16 * fq + j];
            struct Raw { u32x2 rr, rk, rv; h4 rs, ra; v4u kn0, kn1; } RA, RB;
#define WS_LOAD(R, c) do { const size_t _row = (size_t)SCAN_ROW(16 * (c) + fr); const bf16* _p = rkv + _row * 3072 + c0; R.rr = *(const u32x2*)_p; R.rk = *(const u32x2*)(_p + 1024); R.rv = *(const u32x2*)(_p + 2048); \
            R.rs = *(const h4*)(lr + _row * NLR + dir * 1024 + c0); R.ra = *(const h4*)(lr + _row * NLR + 2048 + dir * 1024 + c0); \
            R.kn0 = *(const v4u*)(rkv + _row * 3072 + 1024 + h * 64 + 16 * fq); R.kn1 = *(const v4u*)(rkv + _row * 3072 + 1024 + h * 64 + 16 * fq + 8); } while (0)
            WS_LOAD(RA, 0); WS_LOAD(RB, 1);
            __builtin_amdgcn_s_setprio(2);
            auto stage = [&](const int t, Raw& R, const int Q3) __attribute__((always_inline)) {
                {
                    unsigned char* O = L + Q3 * WSO_BYTES;
                    bf16* At = (bf16*)O; bf16* Bt = At + 16 * SC_LDL; bf16* Kt = Bt + 16 * SC_LDL; bf16* Rt = Kt + 16 * SC_LDL;
                    bf16* BhT = Rt + 16 * SC_LDL; bf16* KhT = BhT + 64 * SC_LDJ; bf16* Vt = KhT + 64 * SC_LDJ; float* gc = (float*)(Vt + 64 * SC_LDJ);
                    const float kf[4] = {bflo(R.rk.x), bfhi(R.rk.x), bflo(R.rk.y), bfhi(R.rk.y)}, rf[4] = {bflo(R.rr.x), bfhi(R.rr.x), bflo(R.rr.y), bfhi(R.rr.y)};
                    const unsigned vb0 = R.rv.x, vb1 = R.rv.y;
                    const unsigned knu[8] = {R.kn0.x, R.kn0.y, R.kn0.z, R.kn0.w, R.kn1.x, R.kn1.y, R.kn1.z, R.kn1.w};
                    f32x2v sq2 = (f32x2v){0.f, 0.f};
#pragma unroll
                    for (int j = 0; j < 8; ++j) { const f32x2v x = (f32x2v){bflo(knu[j]), bfhi(knu[j])} * (f32x2v){kkn[2 * j], kkn[2 * j + 1]}; sq2 += x * x; }
                    float sq = sq2.x + sq2.y;
                    sq += __shfl_xor(sq, 16); sq += __shfl_xor(sq, 32);
                    const float inv = __builtin_amdgcn_rsqf(fmaxf(sq, 1e-24f));
                    float nn[4], aa[4], kd[4], lwv[4];
#pragma unroll
                    for (int j = 0; j < 4; ++j) { nn[j] = kf[j] * kko[j] * inv; aa[j] = fsigmoid((float)R.ra[j] + iav[j]); const float sd = fsigmoid((float)R.rs[j] + dwv[j]);
                        kd[j] = kf[j] * (1.f + (aa[j] - 1.f) * kav[j]); lwv[j] = -0.60653065971f * sd; }
                    { const int tn = (t + 2 < 272) ? t + 2 : 271; WS_LOAD(R, tn); }
                    float at[4], bt[4], kt[4], rt[4], bh[4], kh[4], gt[4];
#pragma unroll
                    for (int j = 0; j < 4; ++j) {
                        float cum = lwv[j]; cum += DPP_F(cum, 0x111); cum += DPP_F(cum, 0x112); cum += DPP_F(cum, 0x114); cum += DPP_F(cum, 0x118);
                        const float tot = __builtin_bit_cast(float, __builtin_amdgcn_ds_swizzle(__builtin_bit_cast(int, cum), 0x1F0));
                        const float G = __expf(cum), GT = __expf(tot), I = __builtin_amdgcn_rcpf(G), E = GT * I;
                        const float P = __builtin_bit_cast(float, __builtin_amdgcn_update_dpp(0x3f800000, __builtin_bit_cast(int, G), 0x111, 0xF, 0xF, false));
                        const float na = nn[j] * aa[j];
                        at[j] = -nn[j] * P; bt[j] = na * I; kt[j] = kd[j] * I; rt[j] = rf[j] * G; bh[j] = na * E; kh[j] = kd[j] * E; gt[j] = GT; }
                    *(u32x2*)(At + fr * SC_LDL + cl) = (u32x2){pg8::cvt_pk_bf16(at[0], at[1]), pg8::cvt_pk_bf16(at[2], at[3])};
                    *(u32x2*)(Bt + fr * SC_LDL + cl) = (u32x2){pg8::cvt_pk_bf16(bt[0], bt[1]), pg8::cvt_pk_bf16(bt[2], bt[3])};
                    *(u32x2*)(Kt + fr * SC_LDL + cl) = (u32x2){pg8::cvt_pk_bf16(kt[0], kt[1]), pg8::cvt_pk_bf16(kt[2], kt[3])};
                    *(u32x2*)(Rt + fr * SC_LDL + cl) = (u32x2){pg8::cvt_pk_bf16(rt[0], rt[1]), pg8::cvt_pk_bf16(rt[2], rt[3])};
#pragma unroll
                    for (int j = 0; j < 4; j += 2) { const unsigned pb = pg8::cvt_pk_bf16(bh[j], bh[j + 1]), pk = pg8::cvt_pk_bf16(kh[j], kh[j + 1]);
                        BhT[(cl + j) * SC_LDJ + fr] = (bf16)(pb & 0xffffu); BhT[(cl + j + 1) * SC_LDJ + fr] = (bf16)(pb >> 16);
                        KhT[(cl + j) * SC_LDJ + fr] = (bf16)(pk & 0xffffu); KhT[(cl + j + 1) * SC_LDJ + fr] = (bf16)(pk >> 16); }
                    Vt[(cl + 0) * SC_LDJ + fr] = (bf16)(vb0 & 0xffffu); Vt[(cl + 1) * SC_LDJ + fr] = (bf16)(vb0 >> 16);
                    Vt[(cl + 2) * SC_LDJ + fr] = (bf16)(vb1 & 0xffffu); Vt[(cl + 3) * SC_LDJ + fr] = (bf16)(vb1 >> 16);
                    if (fr == 15) *(f32x4*)(gc + cl) = (f32x4){gt[0], gt[1], gt[2], gt[3]};
                }
            };
            auto mats = [&](const int Q3P, const int PAR) __attribute__((always_inline)) {
                {
                    unsigned char* O = L + Q3P * WSO_BYTES; unsigned char* X = L + 3 * WSO_BYTES + PAR * WSX_BYTES;
                    const bf16* At = (const bf16*)O; const bf16* Bt = At + 16 * SC_LDL; const bf16* Kt = Bt + 16 * SC_LDL; const bf16* Rt = Kt + 16 * SC_LDL;
                    float* Mf = (float*)X; bf16* Mak = (bf16*)(X + 16 * 17 * 4); bf16* Nrb = Mak + 16 * SC_LDJ; bf16* Nrk = Nrb + 16 * SC_LDJ;
                    const bf16* Xo = (wv < 2) ? At : Rt; const bf16* Yo = (wv & 1) ? Kt : Bt; f32x4 m = (f32x4){0.f, 0.f, 0.f, 0.f};
#pragma unroll
                    for (int ks = 0; ks < 2; ++ks) m = __builtin_amdgcn_mfma_f32_16x16x32_bf16(sc_frag(Xo, SC_LDL, fr, 32 * ks + 8 * fq), sc_frag(Yo, SC_LDL, fr, 32 * ks + 8 * fq), m, 0, 0, 0);
#pragma unroll
                    for (int e = 0; e < 4; ++e) { const int i = 4 * fq + e; const bool keep = (wv < 2) ? (fr < i) : (fr <= i); m[e] = keep ? m[e] : 0.f; }
                    if (wv == 0) {
                        *(f32x2v*)(Mf + ((2 * fq) * 16 + fr) * 2) = (f32x2v){m[0], m[1]}; *(f32x2v*)(Mf + ((2 * fq + 1) * 16 + fr) * 2) = (f32x2v){m[2], m[3]};
                    } else { bf16* Mo = (wv == 1) ? Mak : (wv == 2) ? Nrb : Nrk; const unsigned p01 = pg8::cvt_pk_bf16(m[0], m[1]), p23 = pg8::cvt_pk_bf16(m[2], m[3]);
                        Mo[(4 * fq + 0) * SC_LDJ + fr] = (bf16)(p01 & 0xffffu); Mo[(4 * fq + 1) * SC_LDJ + fr] = (bf16)(p01 >> 16);
                        Mo[(4 * fq + 2) * SC_LDJ + fr] = (bf16)(p23 & 0xffffu); Mo[(4 * fq + 3) * SC_LDJ + fr] = (bf16)(p23 >> 16); }
                }
            };
            stage(0, RA, 0); WG_BAR_LDS();
            stage(1, RB, 1); mats(0, 0); WG_BAR_LDS();
            for (int tb = 2; tb < 272; tb += 6) {
#pragma unroll
                for (int k = 0; k < 6; ++k) { if (k & 1) stage(tb + k, RB, (2 + k) % 3); else stage(tb + k, RA, (2 + k) % 3);
                    mats((1 + k) % 3, (1 + k) & 1); WG_BAR_LDS(); } }
            mats(271 % 3, 271 & 1); WG_BAR_LDS();
            WG_BAR_LDS();
            __builtin_amdgcn_s_setprio(0);
#undef WS_LOAD
        } else {
            const int tv = wv - 4;
            unsigned char* Pv = L + 3 * WSO_BYTES + 2 * WSX_BYTES + tv * WSC_BYTES;
            bf16* Sbw = (bf16*)Pv; float* Pfw = (float*)(Pv + 16 * SC_LDL * 2); bf16* Utw = (bf16*)(Pv + 16 * SC_LDL * 2 + 16 * 20 * 4);
            f32x4 S[4];
#pragma unroll
            for (int tk = 0; tk < 4; ++tk) S[tk] = (f32x4){0.f, 0.f, 0.f, 0.f};
            __builtin_amdgcn_s_waitcnt(0x0F70);
            auto cons = [&](const int t, const int Q3, const int PAR) __attribute__((always_inline)) {
                { const int c = t - 2;
                    unsigned char* O = L + Q3 * WSO_BYTES; unsigned char* X = L + 3 * WSO_BYTES + PAR * WSX_BYTES;
                    const bf16* At = (const bf16*)O; const bf16* Rt = At + 3 * 16 * SC_LDL;
                    const bf16* BhT = Rt + 16 * SC_LDL; const bf16* KhT = BhT + 64 * SC_LDJ; const bf16* Vt = KhT + 64 * SC_LDJ; const float* gc = (const float*)(Vt + 64 * SC_LDJ);
                    const float* Mf = (const float*)X; const bf16* Mak = (const bf16*)(X + 16 * 17 * 4); const bf16* Nrb = Mak + 16 * SC_LDJ; const bf16* Nrk = Nrb + 16 * SC_LDJ;
                    const sc_bf16x8 sb0 = sc_frag(Sbw, SC_LDL, fr, 8 * fq), sb1 = sc_frag(Sbw, SC_LDL, fr, 32 + 8 * fq);
                    const sc_bf16x8 at0 = sc_frag(At, SC_LDL, fr, 8 * fq), at1 = sc_frag(At, SC_LDL, fr, 32 + 8 * fq), rt0 = sc_frag(Rt, SC_LDL, fr, 8 * fq), rt1 = sc_frag(Rt, SC_LDL, fr, 32 + 8 * fq);
                    const sc_bf16x8 vb = sc_frag(Vt, SC_LDJ, 16 * tv + fr, 8 * fq), mak = sc_frag(Mak, SC_LDJ, fr, 8 * fq), nrk = sc_frag(Nrk, SC_LDJ, fr, 8 * fq), nrb = sc_frag(Nrb, SC_LDJ, fr, 8 * fq);
                    f32x4 mm[28]; f32x2v md[8];
#pragma unroll
                    for (int ip = 0; ip < 5; ++ip) {
#pragma unroll
                        for (int jj = 0; jj < ip; ++jj) mm[ip * (ip - 1) / 2 + jj] = *(const f32x4*)(Mf + (ip * 16 + 2 * jj) * 2);
                        md[ip] = *(const f32x2v*)(Mf + (ip * 16 + 2 * ip) * 2); }
                    __builtin_amdgcn_sched_barrier(0);
                    const f32x4 z4 = (f32x4){0.f, 0.f, 0.f, 0.f};
                    f32x4 accP = __builtin_amdgcn_mfma_f32_16x16x32_bf16(at0, sb0, z4, 0, 0, 0), accY = __builtin_amdgcn_mfma_f32_16x16x32_bf16(rt0, sb0, z4, 0, 0, 0);
                    accP = __builtin_amdgcn_mfma_f32_16x16x32_bf16(at1, sb1, accP, 0, 0, 0); accY = __builtin_amdgcn_mfma_f32_16x16x32_bf16(rt1, sb1, accY, 0, 0, 0);
                    accP = __builtin_amdgcn_mfma_f32_16x16x32_bf16(mak, vb, accP, 0, 0, 0);  accY = __builtin_amdgcn_mfma_f32_16x16x32_bf16(nrk, vb, accY, 0, 0, 0);
#pragma unroll
                    for (int ip = 5; ip < 8; ++ip) {
#pragma unroll
                        for (int jj = 0; jj < ip; ++jj) mm[ip * (ip - 1) / 2 + jj] = *(const f32x4*)(Mf + (ip * 16 + 2 * jj) * 2);
                        md[ip] = *(const f32x2v*)(Mf + (ip * 16 + 2 * ip) * 2); }
                    __builtin_amdgcn_sched_barrier(0);
                    *(f32x4*)(Pfw + fr * 20 + 4 * fq) = accP;
                    f32x4 pq[4];
#pragma unroll
                    for (int q = 0; q < 4; ++q) pq[q] = *(const f32x4*)(Pfw + fr * 20 + 4 * q);
                    float u[16];
#define WS_SUBST(ip) do { f32x2v acc = (f32x2v){pq[(ip) >> 1][2 * ((ip) & 1)], pq[(ip) >> 1][2 * ((ip) & 1) + 1]};   \
                        _Pragma("unroll") for (int jj = 0; jj < (ip); ++jj) { const f32x4 m4 = mm[(ip) * ((ip) - 1) / 2 + jj]; \
                            acc += (f32x2v){m4.x, m4.y} * (f32x2v){u[2 * jj], u[2 * jj]}; acc += (f32x2v){m4.z, m4.w} * (f32x2v){u[2 * jj + 1], u[2 * jj + 1]}; } \
                        u[2 * (ip)] = acc.x; u[2 * (ip) + 1] = acc.y + md[ip].y * acc.x; } while (0)
                    WS_SUBST(0); WS_SUBST(1); WS_SUBST(2); WS_SUBST(3); WS_SUBST(4);
                    sc_bf16x8 bh[4], kh[4]; float gcv[4];
#pragma unroll
                    for (int tk = 0; tk < 4; ++tk) { bh[tk] = sc_frag(BhT, SC_LDJ, 16 * tk + fr, 8 * fq); kh[tk] = sc_frag(KhT, SC_LDJ, 16 * tk + fr, 8 * fq); gcv[tk] = gc[16 * tk + fr]; }
                    __builtin_amdgcn_sched_barrier(0);
                    WS_SUBST(5); WS_SUBST(6); WS_SUBST(7);
#undef WS_SUBST
                    v4u uw;
#pragma unroll
                    for (int q = 0; q < 4; ++q) { const unsigned lo = pg8::cvt_pk_bf16(u[2 * q], u[2 * q + 1]), hi = pg8::cvt_pk_bf16(u[8 + 2 * q], u[8 + 2 * q + 1]); uw[q] = (fq == 0) ? lo : (fq == 1) ? hi : 0u; }
                    const sc_bf16x8 ua = __builtin_bit_cast(sc_bf16x8, uw);
                    accY = __builtin_amdgcn_mfma_f32_16x16x32_bf16(nrb, ua, accY, 0, 0, 0);
#pragma unroll
                    for (int e = 0; e < 4; e += 2) { const unsigned py = pg8::cvt_pk_bf16(accY[e], accY[e + 1]);
                        ydir[((size_t)dir * MT + (size_t)SCAN_ROW(16 * c + 4 * fq + e)) * BW + h * 64 + 16 * tv + fr] = (bf16)(py & 0xffffu);
                        ydir[((size_t)dir * MT + (size_t)SCAN_ROW(16 * c + 4 * fq + e + 1)) * BW + h * 64 + 16 * tv + fr] = (bf16)(py >> 16); }
#pragma unroll
                    for (int tk = 0; tk < 4; ++tk) {
                        S[tk] = S[tk] * gcv[tk];
                        S[tk] = __builtin_amdgcn_mfma_f32_16x16x32_bf16(ua, bh[tk], S[tk], 0, 0, 0);
                        S[tk] = __builtin_amdgcn_mfma_f32_16x16x32_bf16(vb, kh[tk], S[tk], 0, 0, 0); }
#pragma unroll
                    for (int tk = 0; tk < 4; ++tk) {
#pragma unroll
                        for (int e = 0; e < 4; e += 2) { const unsigned ps = pg8::cvt_pk_bf16(S[tk][e], S[tk][e + 1]);
                            Sbw[(4 * fq + e) * SC_LDL + 16 * tk + fr] = (bf16)(ps & 0xffffu); Sbw[(4 * fq + e + 1) * SC_LDL + 16 * tk + fr] = (bf16)(ps >> 16); } }
                }
            };
            WG_BAR_LDS(); WG_BAR_LDS();
            { int q3 = 0;
#pragma nounroll
              for (int t = 2; t < 274; ++t) { cons(t, q3, t & 1); q3 = (q3 == 2) ? 0 : q3 + 1; WG_BAR_LDS(); } }
        }
#undef SCAN_ROW
    }
}

__device__ __forceinline__ void ph_rwkvout(const Ctx& C, int l, int Mrows) {
    const int tid = opaque_tid(C.wave_s), lane = tid & 63, wave = __builtin_amdgcn_readfirstlane(tid >> 6), cG = opaque_s(C.G), cvcu = opaque_s(C.vcu); (void)lane; (void)wave; (void)cG; (void)cvcu;

    const int bidx = opaque_s((int)blockIdx.x), nwg2 = (MT / 256) * (N2 / 256), nl = nwg2 - (nwg2 / cG) * cG, RW_D = (nl > 0 && nl < cG) ? 47 : 0;
    const int xr = (Mrows - (cG - nl) * RW_D) / cG, extra = Mrows - (nl * xr + (cG - nl) * (xr + RW_D));
    const int mlo = (bidx < nl ? bidx * xr : nl * xr + (bidx - nl) * (xr + RW_D)) + (bidx < extra ? bidx : extra);
    const int mhi = mlo + (bidx < nl ? xr : xr + RW_D) + (bidx < extra ? 1 : 0);
    const bf16* rkv = (const bf16*)(C.ws + WS_RKV); const _Float16* lr = (const _Float16*)(C.ws + WS_LR); const bf16* ydir = (const bf16*)(C.ws + WS_Y2); bf16* ya = (bf16*)(C.ws + WS_YA);
    for (int m = mlo + wave; m < mhi; m += NWAVES) {
#pragma unroll
        for (int hp = 0; hp < 8; ++hp) { const int col = hp * 128 + 2 * lane;
            const unsigned wr = *(const unsigned*)(rkv + (size_t)m * 3072 + col), wk = *(const unsigned*)(rkv + (size_t)m * 3072 + 1024 + col), wvv = *(const unsigned*)(rkv + (size_t)m * 3072 + 2048 + col);
            const unsigned yf = *(const unsigned*)(ydir + (size_t)m * BW + col), ybk = *(const unsigned*)(ydir + ((size_t)MT + m) * BW + col);
            const h2 p0 = *(const h2*)(lr + (size_t)m * NLR + 2048 + col), p1 = *(const h2*)(lr + (size_t)m * NLR + 3072 + col), gg = *(const h2*)(lr + (size_t)m * NLR + 4096 + col);
            const f32x2v b0 = *(const f32x2v*)(C.inp(I_A0) + (l * 2 + 0) * BW + col), b1 = *(const f32x2v*)(C.inp(I_A0) + (l * 2 + 1) * BW + col);
            const f32x2v a0 = (f32x2v){fsigmoid((float)p0[0] + b0.x), fsigmoid((float)p0[1] + b0.y)}, a1 = (f32x2v){fsigmoid((float)p1[0] + b1.x), fsigmoid((float)p1[1] + b1.y)};
            const f32x2v ka = *(const f32x2v*)(C.inp(I_KA) + l * BW + col), rk = *(const f32x2v*)(C.inp(I_RK) + l * BW + col), lw = *(const f32x2v*)(C.inp(I_LNW) + l * BW + col), lb = *(const f32x2v*)(C.inp(I_LNB) + l * BW + col);
            const float y0 = bflo(yf) + bflo(ybk), y1 = bfhi(yf) + bfhi(ybk);
            float s1 = y0 + y1;
            float bon = bflo(wr) * rk.x * bflo(wk) * (2.f + (a0.x + a1.x - 2.f) * ka.x) + bfhi(wr) * rk.y * bfhi(wk) * (2.f + (a0.y + a1.y - 2.f) * ka.y);
#pragma unroll
            for (int o = 1; o < 32; o <<= 1) { s1 += __shfl_xor(s1, o); bon += __shfl_xor(bon, o); }
            const float mu = s1 * (1.f / 64.f), e0 = y0 - mu, e1 = y1 - mu; float s2 = e0 * e0 + e1 * e1;
#pragma unroll
            for (int o = 1; o < 32; o <<= 1) s2 += __shfl_xor(s2, o);
            const float rstd = rsqrtf(s2 * (1.f / 64.f) + 64e-5f);
            const float o0 = ((e0 * rstd) * lw.x + lb.x + bon * bflo(wvv)) * (float)gg[0], o1 = ((e1 * rstd) * lw.y + lb.y + bon * bfhi(wvv)) * (float)gg[1];
            *(unsigned*)(ya + (size_t)m * BW + col) = pk2(o0, o1); }
    }
}

__device__ __forceinline__ void ph_attn(const Ctx& C, int l, bool ctx_out) {
    const att::bf16* Z2 = (const att::bf16*)(C.ws + WS_Z); att::bf16* yc = (att::bf16*)(C.ws + WS_YC);
    float* tmp = (float*)(C.ws + WS_ATMP) + (size_t)blockIdx.x * 256 * 128;
    const float lam = ((const float*)(C.ws + WS_MISC))[2048 + l];
    const float lam_init = 0.8f - 0.6f * expf(-0.3f * (float)l);
    const float* subg = C.inp(I_SUBG) + l * 128;
    const int cG = opaque_s(C.G), cvcu = opaque_s(C.vcu);
    for (int i = 0;; ++i) {
        const int u = i * cG + cvcu;
        int qrow0, klat0, kctx0, nlat, NT, h;
        if (u < 1024) { const int b = u >> 7; h = (u >> 4) & 7; const int qb = u & 15; qrow0 = b * SEQ + qb * 256; klat0 = b * SEQ; kctx0 = ML + b * CTXL; nlat = 64; NT = 68; }
        else if (ctx_out && u < 1024 + 64) { const int uc = u - 1024, b = uc >> 3; h = uc & 7; qrow0 = ML + b * CTXL; klat0 = 0; kctx0 = ML + b * CTXL; nlat = 0; NT = 4; }
        else break;
        att::body<0>(Z2, qrow0, klat0, kctx0, nlat, NT, h * 128, 1024 + h * 128, 2048 + h * 128, tmp, nullptr, 0.f, subg, 0.f, (char*)C.lds, C.wave_s);
        att::body<1>(Z2, qrow0, klat0, kctx0, nlat, NT, h * 128 + 64, 1024 + h * 128 + 64, 2048 + h * 128, tmp, yc + (size_t)qrow0 * BW + h * 128, lam, subg, 1.f - lam_init, (char*)C.lds, C.wave_s);
    }
    __syncthreads();
}

__device__ __forceinline__ Ctx ctx_sub(const Ctx& C, int idx, int cnt) { Ctx c2 = C; c2.vcu = idx; c2.G = cnt; return c2; }

constexpr int PH_PER_LAYER = 12, N_PHASES = 1 + DEPTH * PH_PER_LAYER + 1;
struct Args { const float* in[N_IN]; float* out; unsigned char* ws; int ph_lo, ph_hi, bar_region, pad; };
template <unsigned KMASK> __device__ __forceinline__ void mk_body(const Args& args) {
    extern __shared__ __attribute__((aligned(16))) unsigned char lds[];
    Ctx C;
    C.lds = lds; C.wave_s = __builtin_amdgcn_readfirstlane((int)threadIdx.x >> 6);
    C.G = gridDim.x; { const int bx = blockIdx.x; C.vcu = (C.G % 8 == 0) ? (bx % 8) * (C.G / 8) + bx / 8 : bx; }
    C.ka = (const float* const __attribute__((address_space(4)))*)__builtin_amdgcn_kernarg_segment_ptr();
    C.out = args.out; C.ws = args.ws;
    LAS unsigned char* ldsl = (LAS unsigned char*)lds;
    for (int u = opaque_tid(C.wave_s); u < (LDS_BYTES - LDSCTL_OFF) / 4; u += NTHR) ((LAS unsigned*)(ldsl + LDSCTL_OFF))[u] = 0u;
    __syncthreads();
    const int lo = args.ph_lo, hi = args.ph_hi;
    const bool multi = (hi - lo) > 1;
    XcdBarrier bar; bar.bar = (unsigned*)(C.ws + WS_CTL) + CW_BAR + args.bar_region * XCD_BAR_WORDS; bar.x = 0; bar.st = nullptr;
    if (multi) bar = xcd_barrier_post((unsigned*)(C.ws + WS_CTL) + CW_BAR + args.bar_region * XCD_BAR_WORDS, (volatile LAS unsigned*)(ldsl + MISC_OFF) + 8, opaque_tid(C.wave_s) == 0);
#define IN(k) (lo <= (k) && (k) < hi)
#define EN(b) ((KMASK >> (b)) & 1u)
#define SEAM(k) do { if (IN((k) + 1)) xcd_barrier(bar, opaque_tid(C.wave_s) == 0); } while (0)
    using namespace pg8;
    bf16_t* const H = (bf16_t*)(C.ws + WS_H); bf16_t* const Z = (bf16_t*)(C.ws + WS_Z);
    float* const mods_all = (float*)(C.ws + WS_MODS);

    if (EN(0) && IN(0)) { ph_mods(C); SEAM(0); }
    for (int l = 0; l < DEPTH; ++l) {
        const int p0 = 1 + l * PH_PER_LAYER;
        if (hi <= p0 || lo >= p0 + PH_PER_LAYER) continue;
        const bool ctx_out = l < DEPTH - 1;
        const int Mx = ctx_out ? MT : ML;
        const float* mods_l = mods_all + (size_t)l * 9 * NMODC;
#define G opaque_s(C.G)
#define bid opaque_s((int)blockIdx.x)
#define MK_WPREP_TAIL(lo, hi, pool) do { if (l + 1 < DEPTH) { const int _G = G, _b = bid, _nwg = (Mx / 256) * (DM / 256), _nl = _nwg - (_nwg / _G) * _G; \
            if (_b >= _nl) { const Ctx C2 = ctx_sub(C, _b - _nl, _G - _nl); ph_wprep(C2, l + 1, (lo), (hi), 6, (pool)); } } } while (0)
        if (EN(1) && IN(p0 + 0)) { if (l == 0) ph_wprep(C, l); ph_norm(C, l, 0, MT); SEAM(p0 + 0); }
        if (EN(2) && IN(p0 + 1)) { Gemm g{H, (const bf16_t*)(C.ws + WSP(l) + WS_W1T), MT, N1, DM, DM}; StaticOrder S; S.init(MT, N1, G, bid, 4); EpiZ1 E{Z};
            gemm_phase<EpiZ1, StaticOrder, true, true>(ldsl, g, S, E, C.wave_s); SEAM(p0 + 1); }
        if (EN(3) && IN(p0 + 2)) { ph_convpool(C, l);
            Gemm g{Z + 3072, (const bf16_t*)(C.ws + WSP(l) + WS_WLRT), MT, NLR, KLR, N1};
            StaticOrder S; S.init(MT, NLR, G, bid, 4);
            EpiLr E{(_Float16*)(C.ws + WS_LR)};
            gemm_phase<EpiLr, StaticOrder, true, true>(ldsl, g, S, E, C.wave_s); SEAM(p0 + 2); }
        if (EN(4) && IN(p0 + 3)) { if (SCAN_CHUNKED == 2) ph_scan_ws(C, l); else if (SCAN_CHUNKED) ph_scan_chunk(C, l); else ph_scan(C, l); SEAM(p0 + 3); }
        if (EN(5) && IN(p0 + 4)) { ph_rwkvout(C, l, Mx);
            Gemm g{H, (const bf16_t*)(C.ws + WSP(l) + WS_W2T), MT, N2, DM, DM}; StaticOrder S; S.init(MT, N2, G, bid, 4); EpiZ2 E{Z, (const float*)(C.ws + WS_MISC), (const float*)(C.ws + WS_MISC) + 1024};
            gemm_phase<EpiZ2, StaticOrder, true, true>(ldsl, g, S, E, C.wave_s); SEAM(p0 + 4); }
        if (EN(6) && IN(p0 + 5)) { ph_attn(C, l, ctx_out); SEAM(p0 + 5); }
        if (EN(7) && IN(p0 + 6)) {
            Gemm g{H, (const bf16_t*)(C.ws + WSP(l) + WS_W3T), Mx, N3, DM, DM};
            StaticOrder S; S.init(Mx, N3, G, bid, 4);
            EpiGate E{Z};
            gemm_phase<EpiGate, StaticOrder, true, true>(ldsl, g, S, E, C.wave_s);
            SEAM(p0 + 6); }
        if (EN(8) && IN(p0 + 7)) { bf16_t* accb = (bf16_t*)(C.ws + WS_RKV); const bf16_t* WB = (const bf16_t*)(C.ws + WSP(l) + WS_WBT);
            StaticOrder S; S.init(Mx, DM, G, bid, 2);
            { Gemm g{(const bf16_t*)(C.ws + WS_YA), WB, Mx, DM, BW, BW}; EpiMerge<0> E{Z, accb}; gemm_phase<EpiMerge<0>, StaticOrder, true, true>(ldsl, g, S, E, C.wave_s); } MK_WPREP_TAIL(0, 1, false);
            { Gemm g{(const bf16_t*)(C.ws + WS_POOL), WB + (size_t)DM * BW, Mx, DM, BW, BW}; EpiMerge<1> E{Z, accb}; gemm_phase<EpiMerge<1>, StaticOrder, true, true>(ldsl, g, S, E, C.wave_s); } MK_WPREP_TAIL(1, 2, false);
            { Gemm g{(const bf16_t*)(C.ws + WS_YC), WB + (size_t)2 * DM * BW, Mx, DM, BW, BW}; EpiMerge<2> E{Z, accb}; gemm_phase<EpiMerge<2>, StaticOrder, true, true>(ldsl, g, S, E, C.wave_s); } MK_WPREP_TAIL(2, 3, false);
            SEAM(p0 + 7); }
        if (EN(9) && IN(p0 + 8)) { Gemm g{(const bf16_t*)(C.ws + WS_RKV), (const bf16_t*)(C.ws + WSP(l) + WS_WOT), Mx, DM, DM, DM}; StaticOrder S; S.init(Mx, DM, G, bid, 2);
            EpiRes E{l == 0 ? C.inp(I_X) : C.out, C.out, l == 0 ? C.inp(I_CTX) : (const float*)(C.ws + WS_XC), (float*)(C.ws + WS_XC), mods_l + 2 * DM,
                     1.0f};
            gemm_phase<EpiRes, StaticOrder, true, true>(ldsl, g, S, E, C.wave_s); MK_WPREP_TAIL(3, 4, false); SEAM(p0 + 8); }
        if (EN(10) && IN(p0 + 9)) { ph_norm(C, l, 1, Mx); SEAM(p0 + 9); }
        if (EN(11) && IN(p0 + 10)) { Gemm g{H, (const bf16_t*)(C.ws + WSP(l) + WS_WFIT), Mx, NFI, DM, DM}; StaticOrder S; S.init(Mx, NFI, G, bid, 4); EpiSwiglu E{Z};
            gemm_phase<EpiSwiglu, StaticOrder, true, true>(ldsl, g, S, E, C.wave_s); SEAM(p0 + 10); }
        if (EN(12) && IN(p0 + 11)) { Gemm g{Z, (const bf16_t*)(C.ws + WSP(l) + WS_WFOT), Mx, DM, DFF, DFF}; StaticOrder S; S.init(Mx, DM, G, bid, 2);
            EpiRes E{C.out, C.out, (const float*)(C.ws + WS_XC), (float*)(C.ws + WS_XC), mods_l + 5 * DM, 1.0f};
            gemm_phase<EpiRes, StaticOrder, true, true>(ldsl, g, S, E, C.wave_s); MK_WPREP_TAIL(4, 6, true); SEAM(p0 + 11); }
    }
#undef MK_WPREP_TAIL
#undef G
#undef bid
    if (EN(13) && IN(N_PHASES - 1)) ph_final(C);
#undef IN
#undef SEAM
}


#ifndef PH_MASK
#define PH_MASK 0xFFFFu
#endif
template <unsigned KMASK> __global__ void __launch_bounds__(NTHR, 2) mk_k(Args args) {
    mk_body<KMASK>(args);
}
#if !MK_SPLIT
__global__ void __launch_bounds__(NTHR, 2) mk_fwd(Args args) { mk_body<PH_MASK>(args); }
#endif
static inline int kind_of(int p) { return p == 0 ? 0 : p == N_PHASES - 1 ? 13 : 1 + (p - 1) % PH_PER_LAYER; }
typedef void (*kern_t)(Args);
static kern_t kern_of(int kind) {
    switch (kind) { case 0: return mk_k<1u << 0>; case 1: return mk_k<1u << 1>; case 2: return mk_k<1u << 2>; case 3: return mk_k<1u << 3>; case 4: return mk_k<1u << 4>; case 5: return mk_k<1u << 5>; case 6: return mk_k<1u << 6>;
                    case 7: return mk_k<1u << 7>; case 8: return mk_k<1u << 8>; case 9: return mk_k<1u << 9>; case 10: return mk_k<1u << 10>; case 11: return mk_k<1u << 11>; case 12: return mk_k<1u << 12>; default: return mk_k<1u << 13>; }
}
extern "C" void kernel_launch(void* const* d_in, const int* in_sizes, int n_in, void* d_out, int out_size, void* d_ws, size_t ws_size, hipStream_t stream) {
    static int grid = 0;
    if (grid == 0) {
        if (n_in != N_IN || out_size != ML * DM || ws_size < WS_END) { fprintf(stderr, "kernel_launch: shape mismatch: n_in %d out %d ws %zu (need %zu)\n", n_in, out_size, ws_size, (size_t)WS_END); grid = -1; return; }
        int dev = 0, cus = 0, per_cu = 0;
        if (hipGetDevice(&dev) != hipSuccess || hipDeviceGetAttribute(&cus, hipDeviceAttributeMultiprocessorCount, dev) != hipSuccess) { grid = -1; return; }
#if MK_SPLIT
        for (int k = 0; k < 14; ++k) if (hipFuncSetAttribute((const void*)kern_of(k), hipFuncAttributeMaxDynamicSharedMemorySize, LDS_BYTES) != hipSuccess) { fprintf(stderr, "kernel_launch: hipFuncSetAttribute failed (kind %d)\n", k); grid = -1; return; }
        (void)per_cu;
#else
        if (hipFuncSetAttribute((const void*)mk_fwd, hipFuncAttributeMaxDynamicSharedMemorySize, LDS_BYTES) != hipSuccess) { fprintf(stderr, "kernel_launch: hipFuncSetAttribute failed\n"); grid = -1; return; }
        if (hipOccupancyMaxActiveBlocksPerMultiprocessor(&per_cu, (const void*)mk_fwd, NTHR, LDS_BYTES) != hipSuccess || per_cu < 1) fprintf(stderr, "kernel_launch: occupancy query says %d\n", per_cu);
#endif
        (void)hipGetLastError();
        grid = cus;
    }
    if (grid < 0) return;
    if (hipMemsetAsync((char*)d_ws + WS_CTL, 0, CTL_ZERO_BYTES, stream) != hipSuccess) { fprintf(stderr, "kernel_launch: memset failed\n"); return; }
    Args a{};
    for (int i = 0; i < N_IN; ++i) a.in[i] = (const float*)d_in[i];
    a.out = (float*)d_out; a.ws = (unsigned char*)d_ws; a.bar_region = 0; a.pad = 0;
#if MK_SPLIT
    for (int p = 0; p < N_PHASES; ++p) {
        a.ph_lo = p; a.ph_hi = p + 1;
        const int kind = kind_of(p);
        hipLaunchKernelGGL(kern_of(kind), dim3(grid), dim3(NTHR), LDS_BYTES, stream, a);
    }
#else
    a.ph_lo = 0; a.ph_hi = N_PHASES; hipLaunchKernelGGL(mk_fwd, dim3(grid), dim3(NTHR), LDS_BYTES, stream, a);
#endif
    const hipError_t le = hipPeekAtLastError();
    if (le != hipSuccess) fprintf(stderr, "kernel_launch: launch failed: %s\n", hipGetErrorName(le));
}
```
